# Optimizing an MI355X kernel written in HIP

```python
import math
import jax, jax.numpy as jnp
from jax import lax
import numpy as np

D_MODEL = 2048
BATCH = 1
SEQ = 16384
DEPTH = 1

EPS = 1e-6
SSM_D_INNER = 2 * D_MODEL
SSM_HEAD_DIM = 64
SSM_N_HEADS = SSM_D_INNER // SSM_HEAD_DIM
SSM_N_GROUPS = 8
SSM_HEADS_PER_GROUP = SSM_N_HEADS // SSM_N_GROUPS
SSM_D_STATE = 128
SSM_CONV = 4
SSM_CHUNK = 128
SSM_CONV_DIM = SSM_D_INNER + 2 * SSM_N_GROUPS * SSM_D_STATE
SSM_PROJ = SSM_D_INNER + SSM_CONV_DIM + SSM_N_HEADS
GDN_N_HEADS = 16
GDN_HEAD_K = 128
GDN_HEAD_V = 256
GDN_KEY_DIM = GDN_N_HEADS * GDN_HEAD_K
GDN_VAL_DIM = GDN_N_HEADS * GDN_HEAD_V
GDN_CONV = 4
GDN_CHUNK = 64
GDN_CONV_DIM = 2 * GDN_KEY_DIM + GDN_VAL_DIM
GDN_PROJ = GDN_CONV_DIM + GDN_VAL_DIM + 2 * GDN_N_HEADS
N_BRANCHES = 2
GATE_PROJ = N_BRANCHES * D_MODEL
IN_PROJ = SSM_PROJ + GDN_PROJ + GATE_PROJ
PEER_HEADS = 8
PEER_N_KEYS = 128
PEER_N_EXPERTS = PEER_N_KEYS * PEER_N_KEYS
PEER_D_KEY = 256
PEER_HALF = PEER_D_KEY // 2
PEER_TOPK = 16
PEER_TOKEN_BLOCK = 128

kernel_name = "hybrid_ssd_gdn_peer_block"


def _rms_norm(x, w):
    xf = x.astype(jnp.float32)
    y = xf * lax.rsqrt(jnp.mean(xf * xf, axis=-1, keepdims=True) + EPS)
    return (y * w.astype(jnp.float32)).astype(x.dtype)


def _l2norm(x):
    return x * lax.rsqrt(jnp.sum(x * x, axis=-1, keepdims=True) + EPS)


def _causal_dwconv(x, w):
    k_w, t = w.shape[0], x.shape[1]
    xp = jnp.pad(x, ((0, 0), (k_w - 1, 0), (0, 0)))
    y = xp[:, 0:t] * w[0]
    for k in range(1, k_w):
        y = y + xp[:, k:k + t] * w[k]
    return y


def _ssd_branch(p, conv_w, conv_b, dt_bias, a_log, d_skip, norm_w):
    f32 = jnp.float32
    b_, t, _ = p.shape
    L, G, R, P, N = SSM_CHUNK, SSM_N_GROUPS, SSM_HEADS_PER_GROUP, SSM_HEAD_DIM, SSM_D_STATE
    nc = t // L
    z, xbc, dt = jnp.split(p, [SSM_D_INNER, SSM_D_INNER + SSM_CONV_DIM], axis=-1)
    xbc = jax.nn.silu(_causal_dwconv(xbc, conv_w) + conv_b).astype(f32)
    xs, bm, cm = jnp.split(xbc, [SSM_D_INNER, SSM_D_INNER + G * N], axis=-1)
    x = xs.reshape(b_, nc, L, G, R, P)
    bm = bm.reshape(b_, nc, L, G, N)
    cm = cm.reshape(b_, nc, L, G, N)
    dt = jax.nn.softplus(dt.astype(f32) + dt_bias.astype(f32)).reshape(b_, nc, L, G, R)
    a = -jnp.exp(a_log.astype(f32)).reshape(G, R)
    a_cs = jnp.cumsum(dt * a, axis=2)
    xdt = x * dt[..., None]
    causal = jnp.tril(jnp.ones((L, L), dtype=bool))
    seg = a_cs[:, :, :, None] - a_cs[:, :, None, :]
    decay = jnp.exp(jnp.where(causal[:, :, None, None], seg, -jnp.inf))
    cb = jnp.einsum('bclgn,bcsgn->bclsg', cm, bm)
    scores = cb[..., None] * decay
    y_diag = jnp.einsum('bclsgr,bcsgrp->bclgrp', scores, xdt)
    to_end = jnp.exp(a_cs[:, :, -1:] - a_cs)
    states = jnp.einsum('bcsgn,bcsgrp->bcgrpn', bm, xdt * to_end[..., None])
    c_dec = jnp.exp(a_cs[:, :, -1])

    def step(hs, inp):
        s_c, d_c = inp
        return hs * d_c[..., None, None] + s_c, hs

    h0 = jnp.zeros((b_, G, R, P, N), f32)
    _, h_in = lax.scan(step, h0, (jnp.moveaxis(states, 1, 0), jnp.moveaxis(c_dec, 1, 0)))
    h_in = jnp.moveaxis(h_in, 0, 1)
    y_off = jnp.einsum('bclgn,bcgrpn->bclgrp', cm, h_in) * jnp.exp(a_cs)[..., None]
    y = y_diag + y_off + x * d_skip.astype(f32).reshape(G, R)[:, :, None]
    y = y.reshape(b_, t, SSM_D_INNER) * jax.nn.silu(z.astype(f32))
    yg = y.reshape(b_, t, G, SSM_D_INNER // G)
    yg = yg * lax.rsqrt(jnp.mean(yg * yg, axis=-1, keepdims=True) + EPS)
    y = yg.reshape(b_, t, SSM_D_INNER) * norm_w.astype(f32)
    return y.astype(p.dtype)


def _gdn_branch(p, conv_w, dt_bias, a_log, norm_w):
    f32 = jnp.float32
    b_, t, _ = p.shape
    H, DK, DV, C = GDN_N_HEADS, GDN_HEAD_K, GDN_HEAD_V, GDN_CHUNK
    nc = t // C
    qkv, z, bt, al = jnp.split(
        p, [GDN_CONV_DIM, GDN_CONV_DIM + GDN_VAL_DIM, GDN_CONV_DIM + GDN_VAL_DIM + H], axis=-1)
    qkv = jax.nn.silu(_causal_dwconv(qkv, conv_w)).astype(f32)
    q, k, v = jnp.split(qkv, [GDN_KEY_DIM, 2 * GDN_KEY_DIM], axis=-1)
    q = _l2norm(q.reshape(b_, t, H, DK)) * (DK ** -0.5)
    k = _l2norm(k.reshape(b_, t, H, DK))
    v = v.reshape(b_, t, H, DV)
    beta = jax.nn.sigmoid(bt.astype(f32))
    g = -jnp.exp(a_log.astype(f32)) * jax.nn.softplus(al.astype(f32) + dt_bias.astype(f32))

    def chunked(a):
        return jnp.moveaxis(a.reshape((b_, nc, C) + a.shape[2:]), 2, 3)

    q, k, v, beta, g = chunked(q), chunked(k), chunked(v), chunked(beta), chunked(g)
    gc = jnp.cumsum(g, axis=-1)
    causal = jnp.tril(jnp.ones((C, C), dtype=bool))
    strict = jnp.tril(jnp.ones((C, C), dtype=bool), k=-1)
    decay = jnp.exp(jnp.where(causal, gc[..., :, None] - gc[..., None, :], -jnp.inf))
    kk = jnp.einsum('bnhid,bnhjd->bnhij', k, k)
    lmat = jnp.where(strict, kk * beta[..., :, None] * decay, 0.0)
    eye = jnp.eye(C, dtype=f32)
    t_inv = lax.linalg.triangular_solve(eye + lmat, jnp.broadcast_to(eye, lmat.shape),
                                        left_side=True, lower=True, unit_diagonal=True)
    u = t_inv @ (v * beta[..., None])
    w = t_inv @ (k * (beta * jnp.exp(gc))[..., None])
    attn = jnp.where(causal, jnp.einsum('bnhid,bnhjd->bnhij', q, k) * decay, 0.0)
    q_dec = q * jnp.exp(gc)[..., None]
    k_dec = k * jnp.exp(gc[..., -1:] - gc)[..., None]
    c_dec = jnp.exp(gc[..., -1])

    def step(s, inp):
        u_c, w_c, a_c, q_c, k_c, d_c = inp
        v_new = u_c - w_c @ s
        o_c = q_c @ s + a_c @ v_new
        s = s * d_c[..., None, None] + jnp.swapaxes(k_c, -1, -2) @ v_new
        return s, o_c

    xs = (jnp.moveaxis(u, 1, 0), jnp.moveaxis(w, 1, 0), jnp.moveaxis(attn, 1, 0),
          jnp.moveaxis(q_dec, 1, 0), jnp.moveaxis(k_dec, 1, 0), jnp.moveaxis(c_dec, 1, 0))
    s0 = jnp.zeros((b_, H, DK, DV), f32)
    _, o = lax.scan(step, s0, xs)
    o = jnp.moveaxis(jnp.moveaxis(o, 0, 1), 2, 3).reshape(b_, t, H, DV)
    o = o * lax.rsqrt(jnp.mean(o * o, axis=-1, keepdims=True) + EPS) * norm_w.astype(f32)
    o = o * jax.nn.silu(z.astype(f32).reshape(b_, t, H, DV))
    return o.reshape(b_, t, GDN_VAL_DIM).astype(p.dtype)


def _peer_ffn(xn, w_q, sub_keys, u_tab, v_tab):
    f32 = jnp.float32
    b_, t, d = xn.shape
    q = (xn @ w_q).astype(f32).reshape(b_, t, PEER_HEADS, 2, PEER_HALF)
    s = jnp.einsum('bthpd,hpkd->bthpk', q, sub_keys.astype(f32))
    s1, i1 = lax.top_k(s[..., 0, :], PEER_TOPK)
    s2, i2 = lax.top_k(s[..., 1, :], PEER_TOPK)
    cand = (s1[..., :, None] + s2[..., None, :]).reshape(b_, t, PEER_HEADS, PEER_TOPK * PEER_TOPK)
    cand_idx = (i1[..., :, None] * PEER_N_KEYS + i2[..., None, :]).reshape(
        b_, t, PEER_HEADS, PEER_TOPK * PEER_TOPK)
    top_s, pos = lax.top_k(cand, PEER_TOPK)
    idx = jnp.take_along_axis(cand_idx, pos, axis=-1)
    gate = jax.nn.softmax(top_s, axis=-1).astype(xn.dtype)
    nb = (b_ * t) // PEER_TOKEN_BLOCK
    xb = xn.reshape(nb, PEER_TOKEN_BLOCK, d)
    idx_b = idx.reshape(nb, PEER_TOKEN_BLOCK, PEER_HEADS, PEER_TOPK)
    g_b = gate.reshape(nb, PEER_TOKEN_BLOCK, PEER_HEADS, PEER_TOPK)

    def block(args):
        xt, it, gt = args
        u = u_tab[it]
        act = jax.nn.gelu(jnp.einsum('thkd,td->thk', u, xt), approximate=False)
        return jnp.einsum('thk,thkd->td', gt * act, v_tab[it])

    out = lax.map(block, (xb, idx_b, g_b))
    return out.reshape(b_, t, d)


def setup_inputs(seed: int = 0) -> dict:
    key = jax.random.key(seed)
    ks = jax.random.split(key, 23)
    f32 = jnp.float32

    def nrm(k, shape, scale):
        return jax.random.normal(k, shape, f32) * scale

    def gain(k, shape):
        return 1.0 + 0.02 * jax.random.normal(k, shape, f32)

    def dt_bias(k, shape):
        dt = jnp.exp(jax.random.uniform(k, shape, f32, math.log(1e-3), math.log(1e-1)))
        return dt + jnp.log(-jnp.expm1(-dt))

    def a_log(k, shape):
        return jnp.log(jax.random.uniform(k, shape, f32, 1.0, 16.0))

    return {
        "x": jax.random.normal(ks[0], (BATCH, SEQ, D_MODEL), f32),
        "mix_norm_w": gain(ks[1], (DEPTH, D_MODEL)),
        "w_in": nrm(ks[2], (DEPTH, D_MODEL, IN_PROJ), D_MODEL ** -0.5),
        "gate_b": nrm(ks[3], (DEPTH, N_BRANCHES, D_MODEL), 0.02),
        "ssm_conv_w": nrm(ks[4], (DEPTH, SSM_CONV, SSM_CONV_DIM), SSM_CONV ** -0.5),
        "ssm_conv_b": nrm(ks[5], (DEPTH, SSM_CONV_DIM), 0.02),
        "ssm_dt_bias": dt_bias(ks[6], (DEPTH, SSM_N_HEADS)),
        "ssm_a_log": a_log(ks[7], (DEPTH, SSM_N_HEADS)),
        "ssm_d": 1.0 + 0.1 * jax.random.normal(ks[8], (DEPTH, SSM_N_HEADS), f32),
        "ssm_norm_w": gain(ks[9], (DEPTH, SSM_D_INNER)),
        "gdn_conv_w": nrm(ks[10], (DEPTH, GDN_CONV, GDN_CONV_DIM), GDN_CONV ** -0.5),
        "gdn_dt_bias": dt_bias(ks[11], (DEPTH, GDN_N_HEADS)),
        "gdn_a_log": a_log(ks[12], (DEPTH, GDN_N_HEADS)),
        "gdn_norm_w": gain(ks[13], (DEPTH, GDN_HEAD_V)),
        "w_branch_ssm": nrm(ks[14], (DEPTH, SSM_D_INNER, D_MODEL), SSM_D_INNER ** -0.5),
        "w_branch_gdn": nrm(ks[15], (DEPTH, GDN_VAL_DIM, D_MODEL), GDN_VAL_DIM ** -0.5),
        "w_out": nrm(ks[16], (DEPTH, D_MODEL, D_MODEL), D_MODEL ** -0.5),
        "ffn_norm_w": gain(ks[17], (DEPTH, D_MODEL)),
        "peer_w_q": nrm(ks[18], (DEPTH, D_MODEL, PEER_HEADS * PEER_D_KEY), D_MODEL ** -0.5),
        "peer_sub_keys": nrm(ks[19], (DEPTH, PEER_HEADS, 2, PEER_N_KEYS, PEER_HALF), PEER_HALF ** -0.5),
        "peer_u": nrm(ks[20], (DEPTH, PEER_N_EXPERTS, D_MODEL), D_MODEL ** -0.5),
        "peer_v": nrm(ks[21], (DEPTH, PEER_N_EXPERTS, D_MODEL), PEER_HEADS ** -0.5),
        "final_norm_w": gain(ks[22], (D_MODEL,)),
    }


def reference(x, mix_norm_w, w_in, gate_b, ssm_conv_w, ssm_conv_b, ssm_dt_bias, ssm_a_log,
              ssm_d, ssm_norm_w, gdn_conv_w, gdn_dt_bias, gdn_a_log, gdn_norm_w,
              w_branch_ssm, w_branch_gdn, w_out, ffn_norm_w, peer_w_q, peer_sub_keys,
              peer_u, peer_v, final_norm_w):
    b_, t, _ = x.shape
    h = x
    for l in range(DEPTH):
        xn = _rms_norm(h, mix_norm_w[l])
        proj = xn @ w_in[l]
        p_ssm, p_gdn, p_gate = jnp.split(proj, [SSM_PROJ, SSM_PROJ + GDN_PROJ], axis=-1)
        y_ssm = _ssd_branch(p_ssm, ssm_conv_w[l], ssm_conv_b[l], ssm_dt_bias[l], ssm_a_log[l],
                            ssm_d[l], ssm_norm_w[l]) @ w_branch_ssm[l]
        y_gdn = _gdn_branch(p_gdn, gdn_conv_w[l], gdn_dt_bias[l], gdn_a_log[l],
                            gdn_norm_w[l]) @ w_branch_gdn[l]
        gates = jax.nn.sigmoid(
            (p_gate.reshape(b_, t, N_BRANCHES, D_MODEL) + gate_b[l]).astype(jnp.float32)
        ).astype(x.dtype)
        mixed = gates[:, :, 0] * y_ssm + gates[:, :, 1] * y_gdn
        h = h + mixed @ w_out[l]
        hn = _rms_norm(h, ffn_norm_w[l])
        h = h + _peer_ffn(hn, peer_w_q[l], peer_sub_keys[l], peer_u[l], peer_v[l])
    return _rms_norm(h, final_norm_w)
```

```cpp
#include <hip/hip_runtime.h>
#include <cstdio>
#include <cstdint>
#include <cmath>
namespace pg8 {
#define PG8_LAS __attribute__((address_space(3)))
typedef unsigned short bf16_t;
typedef short bf16x8 __attribute__((ext_vector_type(8)));
typedef float f32x4 __attribute__((ext_vector_type(4)));
typedef unsigned u32x4 __attribute__((ext_vector_type(4)));
constexpr int BM = 256, BK = 64, HALF = 128, HTB = HALF * BK * 2  , STAGE_BYTES = 8 * HTB, NXCD = 8, WGM = 8;

__host__ __device__ __forceinline__ int lds_byte(int r, int c) { const int st = (r >> 4) * 2 + (c >> 5), rr = r & 15, cc = c & 31, ob = rr * 64 + cc * 2; return st * 1024 + (ob ^ (((ob >> 9) & 1) << 5)); }
__host__ __device__ __forceinline__ void stage_rc(int b, int& R, int& C) { const int st = b / 1024, sb = b % 1024, swz = sb ^ (((sb >> 9) & 1) << 5); R = (st >> 1) * 16 + swz / 64; C = (st & 1) * 32 + (swz % 64) / 2; }
__host__ __device__ __forceinline__ int perm32(int rho) { const int n = rho >> 4, i = rho & 15; return 8 * (i >> 2) + 4 * n + (i & 3); }

struct Unit { int pm, pn, z; };
struct Gemm { const bf16_t* A; const bf16_t* Bt; int M, N, K; const bf16_t* A2 = nullptr; const bf16_t* Bt2 = nullptr; };

struct StaticOrder {
    int nM, nN, nwg, G, c;
    __host__ __device__ void init(int M, int N, int G_, int c_) { nM = M / BM; nN = N / BM; nwg = nM * nN; G = G_; c = c_; }
    __host__ __device__ bool next(int i, Unit& u) const {
        const long L = (long)i * G + c; if (L >= nwg) return false;
        int wgid = (int)L; { const int q = nwg / NXCD, r = nwg % NXCD, xcd = wgid % NXCD, off = wgid / NXCD; wgid = (xcd < r ? xcd * (q + 1) : r * (q + 1) + (xcd - r) * q) + off; }
        const int nig = WGM * nN, gid = wgid / nig, fm = gid * WGM, gsz = (nM - fm) < WGM ? (nM - fm) : WGM;
        u.pm = fm + ((wgid % nig) % gsz); u.pn = (wgid % nig) / gsz; u.z = 0; return true;
    }
    __device__ __forceinline__ void a_ready(const Unit&) const {}
    __device__ __forceinline__ void done(const Unit&) const {}
};
struct TwoPassOrder {
    StaticOrder o;
    __host__ __device__ void init(int M, int N, int G_, int c_) { o.init(M, N, G_, c_); }
    __host__ __device__ bool next(int i, Unit& u) const { if (!o.next(i >> 1, u)) return false; u.z = i & 1; return true; }
    __device__ __forceinline__ void a_ready(const Unit&) const {}
    __device__ __forceinline__ void done(const Unit&) const {}
};
__device__ __forceinline__ unsigned cvt_pk_bf16(float lo, float hi) { unsigned r; asm volatile("v_cvt_pk_bf16_f32 %0, %1, %2" : "=v"(r) : "v"(lo), "v"(hi)); return r; }
typedef float f32x2 __attribute__((ext_vector_type(2)));
__device__ __forceinline__ f32x2 gelu_pk(f32x2 v) {
    const f32x2 av = __builtin_elementwise_abs(v), d = av * 0.2316418882f + 1.0f;
    f32x2 t; t.x = __builtin_amdgcn_rcpf(d.x); t.y = __builtin_amdgcn_rcpf(d.y);
    f32x2 q = t * 0.5307027145f + (-0.7265760135f); q = q * t + 0.7107068705f; q = q * t + (-0.142248368f); q = q * t + 0.127414796f; q = q * t;
    const f32x2 s = (v * v) * (-0.72134752044f);
    f32x2 e; e.x = __builtin_amdgcn_exp2f(s.x); e.y = __builtin_amdgcn_exp2f(s.y);
    const f32x2 m = v * (q * e), r = v - m;
    f32x2 o; o.x = v.x < 0.f ? m.x : r.x; o.y = v.y < 0.f ? m.y : r.y; return o;
}
template <class Epi, class Sched, bool ALIGN_EPI = false, bool SP2 = false>
__device__ __forceinline__ void gemm_phase(PG8_LAS unsigned char* lds, const Gemm g, const Sched& S, const Epi& E, int tid_in) {
    int tid_ = tid_in; asm volatile("" : "+v"(tid_));
    const int tid = tid_, wid = __builtin_amdgcn_readfirstlane(tid >> 6), lane = tid & 63, wr = wid >> 2, wc = wid & 3, fr = lane & 15, fq = lane >> 4;
    const int K = g.K, nt = K / BK;
    unsigned voffA[2], voffB[2];
#pragma unroll
    for (int i = 0; i < 2; ++i) { int R, C; stage_rc(tid * 16 + i * 8192, R, C); const int Rb = Epi::PERM ? ((R & ~31) + perm32(R & 31)) : R;
        voffA[i] = (unsigned)(R * K + C) * 2u; voffB[i] = (unsigned)(Rb * K + C) * 2u; }
    const size_t kstep = (size_t)(BK * 2);
    const size_t hstep = (size_t)HALF * K * 2;
    const size_t tstep = 2 * hstep;
    const unsigned ldsw = (unsigned)wid * 1024u;
    const int aoff = lds_byte(wr * 64 + fr, fq * 8), boff = lds_byte(wc * 32 + fr, fq * 8);
#define PG8_SA(b, h) (((b) * 2 + (h)) * HTB)
#define PG8_SB(b, h) ((4 + (b) * 2 + (h)) * HTB)
#define PG8_STAGE(bufoff, gbase, voff) do { _Pragma("unroll") for (int _i = 0; _i < 2; ++_i) \
        __builtin_amdgcn_global_load_lds((const unsigned*)((const char*)(gbase) + (voff)[_i]), (PG8_LAS unsigned*)(lds + (bufoff) + ldsw + _i * 8192), 16, 0, 0); } while (0)
#define PG8_LDA(dst, b, h) do { _Pragma("unroll") for (int m = 0; m < 4; ++m) _Pragma("unroll") for (int k = 0; k < 2; ++k) dst[m][k] = *(const PG8_LAS bf16x8*)(lds + PG8_SA(b, h) + aoff + m * 2048 + k * 1024); } while (0)
#define PG8_LDB(dst, b, h) do { _Pragma("unroll") for (int n = 0; n < 2; ++n) _Pragma("unroll") for (int k = 0; k < 2; ++k) dst[n][k] = *(const PG8_LAS bf16x8*)(lds + PG8_SB(b, h) + boff + n * 2048 + k * 1024); } while (0)
#define PG8_MMA(ai, bj, At, Bt) do { __builtin_amdgcn_s_setprio(1); _Pragma("unroll") for (int m = 0; m < 4; ++m) _Pragma("unroll") for (int n = 0; n < 2; ++n) _Pragma("unroll") for (int k = 0; k < 2; ++k) \
        acc[ai][bj][m][n] = __builtin_amdgcn_mfma_f32_16x16x32_bf16(Bt[n][k], At[m][k], acc[ai][bj][m][n], 0, 0, 0); __builtin_amdgcn_s_setprio(0); } while (0)
#define PG8_WAIT_V(n) asm volatile("s_waitcnt vmcnt(" #n ")" ::: "memory")
#define PG8_WAIT_L(n) asm volatile("s_waitcnt lgkmcnt(" #n ")" ::: "memory")
#define PG8_BAR __builtin_amdgcn_s_barrier()
#define PG8_SCHED __builtin_amdgcn_sched_barrier(0)
    Unit cur, nxt; int ui = 0;
    if (!S.next(0, cur)) return;
    f32x4 acc[2][2][4][2];
#pragma unroll
    for (int a = 0; a < 2; ++a)
#pragma unroll
        for (int b = 0; b < 2; ++b)
#pragma unroll
            for (int m = 0; m < 4; ++m)
#pragma unroll
                for (int n = 0; n < 2; ++n) acc[a][b][m][n] = (f32x4){0.f, 0.f, 0.f, 0.f};
    bf16x8 At[4][2], B0[2][2], B1[2][2];
    const char* cA = (const char*)((Epi::TWO_PASS && cur.z) ? g.A2 : g.A) + (size_t)cur.pm * tstep; const char* cB = (const char*)((Epi::TWO_PASS && cur.z) ? g.Bt2 : g.Bt) + (size_t)cur.pn * tstep;
    S.a_ready(cur);
    if constexpr (SP2) {
        PG8_STAGE(PG8_SB(0, 0), cB, voffB); PG8_STAGE(PG8_SB(0, 1), cB + hstep, voffB); PG8_STAGE(PG8_SA(0, 0), cA, voffA); PG8_STAGE(PG8_SA(0, 1), cA + hstep, voffA);
        if (wr == 1) PG8_BAR;
        PG8_WAIT_V(2); PG8_BAR;
        PG8_STAGE(PG8_SB(1, 0), cB + kstep, voffB); PG8_STAGE(PG8_SA(1, 0), cA + kstep, voffA); PG8_STAGE(PG8_SB(1, 1), cB + hstep + kstep, voffB);
        PG8_WAIT_V(6); PG8_BAR;
    } else {
        PG8_STAGE(PG8_SB(0, 0), cB, voffB); PG8_STAGE(PG8_SA(0, 0), cA, voffA); PG8_STAGE(PG8_SB(0, 1), cB + hstep, voffB); PG8_STAGE(PG8_SA(0, 1), cA + hstep, voffA);
        if (wr == 1) PG8_BAR;
        PG8_WAIT_V(4); PG8_BAR;
        PG8_STAGE(PG8_SB(1, 0), cB + kstep, voffB); PG8_STAGE(PG8_SA(1, 0), cA + kstep, voffA); PG8_STAGE(PG8_SB(1, 1), cB + hstep + kstep, voffB);
        PG8_WAIT_V(6); PG8_BAR;
    }
    for (;;) {
        const bool has_next = S.next(ui + 1, nxt);
        const char* nA = has_next ? (const char*)((Epi::TWO_PASS && nxt.z) ? g.A2 : g.A) + (size_t)nxt.pm * tstep : cA; const char* nB = has_next ? (const char*)((Epi::TWO_PASS && nxt.z) ? g.Bt2 : g.Bt) + (size_t)nxt.pn * tstep : cB;
        for (int t = 0; t < nt; t += 2) {
            const bool last = (t == nt - 2);
            const char* a1 = cA + (size_t)(t + 1) * kstep;
            const char* a2 = last ? nA : cA + (size_t)(t + 2) * kstep; const char* b2 = last ? nB : cB + (size_t)(t + 2) * kstep;
            const char* a3 = a2 + kstep; const char* b3 = b2 + kstep;
            if (last && has_next) S.a_ready(nxt);
            if constexpr (SP2) {
            PG8_LDB(B0, 0, 0); PG8_LDB(B1, 0, 1); PG8_SCHED; PG8_LDA(At, 0, 0); PG8_STAGE(PG8_SA(1, 1), a1 + hstep, voffA);
            PG8_WAIT_V(8); PG8_WAIT_L(0); PG8_BAR; PG8_MMA(0, 0, At, B0); PG8_MMA(0, 1, At, B1); PG8_BAR; PG8_SCHED;
            PG8_LDA(At, 0, 1); PG8_STAGE(PG8_SB(0, 0), b2, voffB); PG8_STAGE(PG8_SB(0, 1), b2 + hstep, voffB); PG8_STAGE(PG8_SA(0, 0), a2, voffA);
            PG8_WAIT_V(8); PG8_WAIT_L(0); PG8_BAR; PG8_MMA(1, 0, At, B0); PG8_MMA(1, 1, At, B1); PG8_BAR; PG8_SCHED;
            PG8_LDB(B0, 1, 0); PG8_LDB(B1, 1, 1); PG8_SCHED; PG8_LDA(At, 1, 0); PG8_STAGE(PG8_SA(0, 1), a2 + hstep, voffA);
            PG8_WAIT_V(8); PG8_WAIT_L(0); PG8_BAR; PG8_MMA(0, 0, At, B0); PG8_MMA(0, 1, At, B1); PG8_BAR; PG8_SCHED;
            PG8_LDA(At, 1, 1); PG8_STAGE(PG8_SB(1, 0), b3, voffB); PG8_STAGE(PG8_SB(1, 1), b3 + hstep, voffB); PG8_STAGE(PG8_SA(1, 0), a3, voffA);
            PG8_WAIT_V(8); PG8_WAIT_L(0); PG8_BAR; PG8_MMA(1, 0, At, B0); PG8_MMA(1, 1, At, B1); PG8_BAR; PG8_SCHED;
            } else {
            PG8_LDB(B0, 0, 0); PG8_SCHED; PG8_LDA(At, 0, 0); PG8_STAGE(PG8_SA(1, 1), a1 + hstep, voffA);
            PG8_WAIT_L(8); PG8_BAR; PG8_WAIT_L(0); PG8_MMA(0, 0, At, B0); PG8_BAR; PG8_SCHED;
            PG8_LDB(B1, 0, 1); PG8_STAGE(PG8_SB(0, 0), b2, voffB);
            PG8_BAR; PG8_WAIT_L(0); PG8_MMA(0, 1, At, B1); PG8_BAR;
            PG8_LDA(At, 0, 1); PG8_STAGE(PG8_SA(0, 0), a2, voffA);
            PG8_BAR; PG8_WAIT_L(0); PG8_MMA(1, 0, At, B0); PG8_BAR; PG8_SCHED;
            PG8_STAGE(PG8_SB(0, 1), b2 + hstep, voffB);
            PG8_WAIT_V(6); PG8_BAR; PG8_MMA(1, 1, At, B1); PG8_BAR;
            PG8_LDB(B0, 1, 0); PG8_SCHED; PG8_LDA(At, 1, 0); PG8_STAGE(PG8_SA(0, 1), a2 + hstep, voffA);
            PG8_WAIT_L(8); PG8_BAR; PG8_WAIT_L(0); PG8_MMA(0, 0, At, B0); PG8_BAR; PG8_SCHED;
            PG8_LDB(B1, 1, 1); PG8_STAGE(PG8_SB(1, 0), b3, voffB);
            PG8_BAR; PG8_WAIT_L(0); PG8_MMA(0, 1, At, B1); PG8_BAR;
            PG8_LDA(At, 1, 1); PG8_STAGE(PG8_SA(1, 0), a3, voffA);
            PG8_BAR; PG8_WAIT_L(0); PG8_MMA(1, 0, At, B0); PG8_BAR; PG8_SCHED;
            PG8_STAGE(PG8_SB(1, 1), b3 + hstep, voffB);
            PG8_WAIT_V(6); PG8_BAR; PG8_MMA(1, 1, At, B1); PG8_BAR;
            }
        }
        if constexpr (ALIGN_EPI) { if (wr == 0) PG8_BAR; }
        bool keep_acc = false;
        if constexpr (Epi::TWO_PASS) { if (cur.z == 0) { E.mid(acc, cur, wr, wc, fr, fq); keep_acc = true; } else { E(acc, cur, wr, wc, fr, fq); S.done(cur); } }
        else if constexpr (!Epi::AFTER_DRAIN) { E(acc, cur, wr, wc, fr, fq); S.done(cur); }
        if (!has_next) break;
        if (!keep_acc)
#pragma unroll
        for (int a = 0; a < 2; ++a)
#pragma unroll
            for (int b = 0; b < 2; ++b)
#pragma unroll
                for (int m = 0; m < 4; ++m)
#pragma unroll
                    for (int n = 0; n < 2; ++n) acc[a][b][m][n] = (f32x4){0.f, 0.f, 0.f, 0.f};
        cur = nxt; cA = nA; cB = nB; ++ui;
        if constexpr (ALIGN_EPI) { if (wr == 1) PG8_BAR; }
    }
    PG8_WAIT_V(0);
    if constexpr (!ALIGN_EPI) { if (wr == 0) PG8_BAR; }
    PG8_BAR;
    if constexpr (Epi::AFTER_DRAIN) { E.fused(acc, cur, wr, wc, fr, fq, lds, wid, lane); S.done(cur); }
#undef PG8_SA
#undef PG8_SB
#undef PG8_STAGE
#undef PG8_LDA
#undef PG8_LDB
#undef PG8_MMA
#undef PG8_WAIT_V
#undef PG8_WAIT_L
#undef PG8_BAR
#undef PG8_SCHED
}
}

#define XB_TMO      128
#define XB_XCNT(j)  (256  + 64 * (j))
#define XB_XSUB(j)  (1280 + 64 * (j))
#define XB_XGEN(j)  (2304 + 64 * (j))
#define XB_TOP      3328
#define XB_TOPGEN   3392
#define XCD_BAR_WORDS 3456
#define XB_SPIN_CAP (1u << 18)
#define LAS __attribute__((address_space(3)))

__device__ __forceinline__ unsigned xb_ld(unsigned* p)              { return __hip_atomic_load(p, __ATOMIC_RELAXED, __HIP_MEMORY_SCOPE_AGENT); }
__device__ __forceinline__ unsigned xb_add(unsigned* p, unsigned v) { return __hip_atomic_fetch_add(p, v, __ATOMIC_RELAXED, __HIP_MEMORY_SCOPE_AGENT); }
__device__ __forceinline__ unsigned xb_xcc_id() { return (unsigned)__builtin_amdgcn_s_getreg((3 << 11) | 20) & 0xFu; }
#define XB_SPIN(cond, bar) do { unsigned _sp = 0; while (cond) { __builtin_amdgcn_s_sleep(1); \
    if ((++_sp & 255u) == 0u) { if (xb_ld(&(bar)[XB_TMO])) break; if (_sp > XB_SPIN_CAP) { atomicAdd(&(bar)[XB_TMO], 1u); break; } } } } while (0)

struct XcdBarrier {
    unsigned* bar; unsigned x;
    volatile LAS unsigned* st;
};

__device__ __forceinline__ XcdBarrier xcd_barrier_post(unsigned* bar, volatile LAS unsigned* st) {
    XcdBarrier b; b.bar = bar; b.x = xb_xcc_id(); b.st = st;
    if (threadIdx.x == 0) (void)xb_add(&bar[XB_XCNT(b.x)], 1u);
    return b;
}
__device__ __forceinline__ void xcd_barrier_complete(unsigned* bar, unsigned x, unsigned& nloc, unsigned& nx) {
    const unsigned G = gridDim.x * gridDim.y * gridDim.z;
    unsigned sum, cnt, mine, sp = 0u;
    for (;;) {
        sum = 0u; cnt = 0u; mine = 0u;
#pragma unroll
        for (unsigned j = 0; j < 16; ++j) { const unsigned c = xb_ld(&bar[XB_XCNT(j)]); sum += c; cnt += (c > 0u) ? 1u : 0u; mine = (j == x) ? c : mine; }
        if (sum == G) break;
        __builtin_amdgcn_s_sleep(1);
        if ((++sp & 255u) == 0u) { if (xb_ld(&bar[XB_TMO])) break; if (sp > XB_SPIN_CAP) { atomicAdd(&bar[XB_TMO], 1u); break; } }
    }
    nloc = mine > 0u ? mine : 1u; nx = cnt > 0u ? cnt : 1u;
}

__device__ __forceinline__ void xcd_barrier(const XcdBarrier& b) {
    asm volatile("s_waitcnt vmcnt(0)" ::: "memory");
    __syncthreads();
    if (threadIdx.x == 0) {
        unsigned* bar = b.bar;
        __builtin_amdgcn_s_waitcnt(0);
        unsigned nloc = b.st[0], nx = b.st[1];
        if (nloc == 0u) { xcd_barrier_complete(bar, b.x, nloc, nx); b.st[0] = nloc; b.st[1] = nx; }
        const unsigned old = xb_add(&bar[XB_XSUB(b.x)], 1u);
        const unsigned gen = old / nloc;
        if (old + 1u == (gen + 1u) * nloc) {
            __builtin_amdgcn_fence(__ATOMIC_RELEASE, "agent");
            asm volatile("s_waitcnt vmcnt(0)" ::: "memory");
            const unsigned og = xb_add(&bar[XB_TOP], 1u);
            const unsigned tg = og / nx;
            if (og + 1u == (tg + 1u) * nx) xb_add(&bar[XB_TOPGEN], 1u);
            else XB_SPIN(xb_ld(&bar[XB_TOPGEN]) == tg, bar);
            __builtin_amdgcn_fence(__ATOMIC_ACQUIRE, "agent");
            xb_add(&bar[XB_XGEN(b.x)], 1u);
            asm volatile("s_waitcnt vmcnt(0)" ::: "memory");
        } else {
            XB_SPIN(xb_ld(&bar[XB_XGEN(b.x)]) == gen, bar);
            __builtin_amdgcn_fence(__ATOMIC_ACQUIRE, "agent");
            asm volatile("s_waitcnt vmcnt(0)" ::: "memory");
        }
    }
    __syncthreads();
}

namespace mk {
using pg8::bf16_t; using pg8::f32x4; using pg8::u32x4; using pg8::bf16x8; using pg8::Unit; using pg8::cvt_pk_bf16;
typedef unsigned u32x2 __attribute__((ext_vector_type(2)));

#ifndef MK_ONE_LAUNCH
#define MK_ONE_LAUNCH 1
#endif

constexpr int T = 16384, D = 2048, TH = 8192, NHALVES = 2;
constexpr int NWAVES = 8, NTHREADS = 512;
constexpr float EPS = 1e-6f;
enum { I_X = 0, I_MIXNW, I_WIN, I_GATEB, I_SCW, I_SCB, I_SDTB, I_SALOG, I_SD, I_SNW, I_GCW, I_GDTB, I_GALOG, I_GNW, I_WBS, I_WBG, I_WOUT, I_FNW, I_WQ, I_SK, I_PU, I_PV, I_FINW, N_IN };
constexpr int IN_PROJ = 26720;
constexpr int NP1 = 26880;

constexpr size_t MiB = 1u << 20;
constexpr size_t WS_CTL = 0, CTL_ZERO_BYTES = 1 * MiB;
constexpr size_t WS_WIN_T = 1 * MiB;
constexpr size_t WS_WBS_T = WS_WIN_T + (size_t)NP1 * 2048 * 2;
constexpr size_t WS_WBG_T = WS_WBS_T + 16 * MiB;
constexpr size_t WS_WOUT_T = WS_WBG_T + 16 * MiB;
constexpr size_t WS_WQ_T = WS_WOUT_T + 8 * MiB;
constexpr size_t WS_SKB = WS_WQ_T + 8 * MiB;
constexpr size_t WS_XN = WS_SKB + 1 * MiB;
constexpr size_t WS_HALF = WS_XN + 64 * MiB;
constexpr size_t WS_ZSSM = WS_HALF;
constexpr size_t WS_XBC = WS_ZSSM + 64 * MiB;
constexpr size_t WS_QKV = WS_XBC + 96 * MiB;
constexpr size_t WS_ZGDN = WS_QKV + 128 * MiB;
constexpr size_t WS_GATES = WS_ZGDN + 64 * MiB;
constexpr size_t WS_SMALL = WS_GATES + 64 * MiB;
constexpr size_t WS_SSQ = WS_SMALL;
constexpr size_t WS_RSTD = WS_SMALL + 2 * MiB;
constexpr size_t WS_MIXED = WS_XBC;
constexpr size_t WS_BCCONV = WS_SMALL + 4 * MiB;
constexpr size_t WS_HALO_XBC = WS_BCCONV + 32 * MiB;
constexpr size_t WS_HALO_QKV = WS_HALO_XBC + 9 * MiB;
constexpr size_t WS_ST_SSD = WS_HALO_QKV + 12 * MiB;
constexpr size_t WS_ST_GDN = WS_ST_SSD + 2 * MiB;
constexpr size_t WS_GW = WS_ST_GDN + 2 * MiB;
constexpr size_t WS_GATT = WS_GW + 32 * MiB;
constexpr size_t WS_U8 = WS_GATT + 16 * MiB;
constexpr size_t WS_V8 = WS_U8 + 32 * MiB;
constexpr size_t WS_GCD = WS_V8 + 32 * MiB;
constexpr size_t WS_SMALLF = WS_GCD + 1 * MiB;
constexpr size_t WS_HALF_END = WS_SMALLF + 8 * MiB;
constexpr size_t WS_Q = WS_HALF;
constexpr size_t WS_PIDX = WS_Q + 64 * MiB;
constexpr size_t WS_PGATE = WS_PIDX + 8 * MiB;
constexpr size_t WS_NEED = WS_HALF_END;
static_assert(WS_PGATE + 8 * MiB <= WS_U8, "q / idx / gate overlay only buffers that are dead after the mixer, below the fp8 tables");
static_assert(WS_NEED <= 835 * MiB, "workspace map exceeds 835 MiB");

constexpr int CW_BAR = 4096;
constexpr int LDS_BYTES = 147456;
constexpr int LDS_CTL_OFF = LDS_BYTES - 256;

__device__ __forceinline__ float bf2f(unsigned short b) { return __uint_as_float(((unsigned)b) << 16); }
__device__ __forceinline__ float bflo(unsigned w) { return __uint_as_float(w << 16); }
__device__ __forceinline__ float bfhi(unsigned w) { return __uint_as_float(w & 0xffff0000u); }
typedef __bf16 bf16v2 __attribute__((ext_vector_type(2)));
typedef float f32x2 __attribute__((ext_vector_type(2)));
__device__ __forceinline__ unsigned pkc(float lo, float hi) { return __builtin_bit_cast(unsigned, __builtin_convertvector((f32x2){lo, hi}, bf16v2)); }
__device__ __forceinline__ unsigned f2bf(float f) { return pkc(f, 0.f) & 0xffffu; }
__device__ __forceinline__ unsigned pk2(float lo, float hi) { return pkc(lo, hi); }
__device__ __forceinline__ float wave_sum(float v) {
#pragma unroll
    for (int o = 1; o < 64; o <<= 1) v += __shfl_xor(v, o);
    return v;
}
__device__ __forceinline__ float sigmoidf_(float x) { return __builtin_amdgcn_rcpf(1.0f + __expf(-x)); }
__device__ __forceinline__ float siluf_(float x) { return x * __builtin_amdgcn_rcpf(1.0f + __expf(-x)); }
__device__ __forceinline__ float softplusf_(float x) {
    const float e = __expf(x); const float s = e * (1.0f + e * (-0.5f + e * (0.33333333f - 0.25f * e)));
    return x > 15.f ? x : (e < 0.03f ? s : __logf(1.0f + e)); }
#define LDS_WAIT() asm volatile("s_waitcnt lgkmcnt(0)" ::: "memory")
#define GAS __attribute__((address_space(1)))
template <class P> __device__ __forceinline__ P* launder_s(P* p) { GAS P* g = (GAS P*)p; asm volatile("" : "+s"(g)); return (P*)g; }

struct Args { const float* in[N_IN]; float* out; unsigned char* ws; int ph_lo, ph_hi; };
static_assert(sizeof(Args) == (N_IN + 2) * 8 + 8, "Args has padding");
struct Ctx {
    const Args* a; float* out; unsigned char* ws;
    LAS unsigned char* lds; int tid, lane, wave, G, bid;
    __device__ __forceinline__ const float* in(int i) const { return (const float*)(const GAS float*)a->in[i]; }
};

__device__ __forceinline__ void transpose_item(const float* W, int ldw, int src_col0, bf16_t* WT, int K, int dst_row0, int k0, LAS float* scr, int lane, const float* ksc = nullptr) {
    float tv[32];
#pragma unroll
    for (int i = 0; i < 32; ++i) tv[i] = W[(size_t)(k0 + 2 * i + (lane >> 5)) * ldw + src_col0 + (lane & 31)];
    if (ksc != nullptr) {
#pragma unroll
        for (int i = 0; i < 32; ++i) tv[i] *= ksc[k0 + 2 * i + (lane >> 5)]; }
#pragma unroll
    for (int i = 0; i < 32; ++i) scr[(2 * i + (lane >> 5)) * 33 + (lane & 31)] = tv[i];
    LDS_WAIT(); asm volatile("" ::: "memory");
    const int c = lane & 7;
#pragma unroll
    for (int j = 0; j < 4; ++j) { const int n = (lane >> 3) + 8 * j; const LAS float* s = scr + (8 * c) * 33 + n;
        u32x4 o; o.x = pk2(s[0 * 33], s[1 * 33]); o.y = pk2(s[2 * 33], s[3 * 33]); o.z = pk2(s[4 * 33], s[5 * 33]); o.w = pk2(s[6 * 33], s[7 * 33]);
        *(u32x4*)(WT + (size_t)(dst_row0 + n) * K + k0 + 8 * c) = o; }
    LDS_WAIT(); asm volatile("" ::: "memory");
}
__device__ __forceinline__ bool seg_do(int& r, const float* W, int ldw, int src_col0, int ncols, bf16_t* WT, int K, int dst_row0, LAS float* scr, int lane, const float* ksc = nullptr) {
    const int nblk = ncols / 32, items = (K / 64) * nblk;
    if (r < items) { const int kb = r / nblk, nb = r % nblk; transpose_item(W, ldw, src_col0 + 32 * nb, WT, K, dst_row0 + 32 * nb, 64 * kb, scr, lane, ksc); return true; }
    r -= items; return false;
}
__device__ __forceinline__ void rms_row_to_bf16(const float* xrow, const float* w, bf16_t* orow, int lane) {
    const f32x4* xr = (const f32x4*)xrow + 2 * lane; f32x4 v[8]; float s = 0.f;
#pragma unroll
    for (int j = 0; j < 4; ++j) { v[2 * j] = xr[128 * j]; v[2 * j + 1] = xr[128 * j + 1]; }
#pragma unroll
    for (int j = 0; j < 8; ++j) s += (v[j].x * v[j].x + v[j].y * v[j].y) + (v[j].z * v[j].z + v[j].w * v[j].w);
    const float r = rsqrtf(wave_sum(s) * (1.0f / 2048.0f) + EPS);
    const f32x4* wr = (const f32x4*)w + 2 * lane; u32x4* o16 = (u32x4*)orow + lane;
#pragma unroll
    for (int j = 0; j < 4; ++j) { const f32x4 g0 = wr[128 * j], g1 = wr[128 * j + 1], a = v[2 * j], b = v[2 * j + 1]; u32x4 o;
        o.x = pk2(a.x * r * g0.x, a.y * r * g0.y); o.y = pk2(a.z * r * g0.z, a.w * r * g0.w); o.z = pk2(b.x * r * g1.x, b.y * r * g1.y); o.w = pk2(b.z * r * g1.z, b.w * r * g1.w);
        o16[64 * j] = o; }
}
__device__ __forceinline__ void late_weights(const Ctx& C, int first_wg) {
    LAS float* scr = (LAS float*)(C.lds + C.wave * 16384);
    const int gw = (C.bid - first_wg) * NWAVES + C.wave, NGW = (C.G - first_wg) * NWAVES;
    for (int it = gw; it < 4096 + 4096 + 2048 + 2048; it += NGW) {
        int r = it;
        if (seg_do(r, C.in(I_WBS), 2048, 0, 2048, (bf16_t*)(C.ws + WS_WBS_T), 4096, 0, scr, C.lane)) continue;
        if (seg_do(r, C.in(I_WBG), 2048, 0, 2048, (bf16_t*)(C.ws + WS_WBG_T), 4096, 0, scr, C.lane)) continue;
        if (seg_do(r, C.in(I_WOUT), 2048, 0, 2048, (bf16_t*)(C.ws + WS_WOUT_T), 2048, 0, scr, C.lane)) continue;
        seg_do(r, C.in(I_WQ), 2048, 0, 2048, (bf16_t*)(C.ws + WS_WQ_T), 2048, 0, scr, C.lane, C.in(I_FNW));
    }
}
__device__ __forceinline__ void p0_prologue(const Ctx& C) {
    LAS float* scr = (LAS float*)(C.lds + C.wave * 16384);
    const int gw = C.bid * NWAVES + C.wave, NGW = C.G * NWAVES;
    bf16_t* WinT = (bf16_t*)(C.ws + WS_WIN_T);
    constexpr int NITEMS = 32 * (320 + 384 + 128 + 2 + 1);
    for (int it = gw; it < NITEMS; it += NGW) {
        int r = it;
        if (seg_do(r, C.in(I_WIN), IN_PROJ, 0, 10240, WinT, 2048, 0, scr, C.lane)) continue;
        if (seg_do(r, C.in(I_WIN), IN_PROJ, 10304, 12288, WinT, 2048, 10240, scr, C.lane)) continue;
        if (seg_do(r, C.in(I_WIN), IN_PROJ, 22624, 4096, WinT, 2048, 22528, scr, C.lane)) continue;
        if (seg_do(r, C.in(I_WIN), IN_PROJ, 10240, 64, WinT, 2048, 26624, scr, C.lane)) continue;
        seg_do(r, C.in(I_WIN), IN_PROJ, 22592, 32, WinT, 2048, 26688, scr, C.lane);
    }
    const int gt = C.bid * NTHREADS + C.tid, NGT = C.G * NTHREADS;
    { u32x4* z = (u32x4*)(WinT + (size_t)26720 * 2048); for (int i = gt; i < 160 * 2048 / 8; i += NGT) z[i] = (u32x4){0u, 0u, 0u, 0u}; }
    { u32x4* z = (u32x4*)(C.ws + WS_ST_SSD); for (int i = gt; i < (int)(4 * MiB / 16); i += NGT) z[i] = (u32x4){0u, 0u, 0u, 0u}; }
    { const float* sk = C.in(I_SK); unsigned* o = (unsigned*)(C.ws + WS_SKB); for (int i = gt; i < 8 * 2 * 128 * 128 / 2; i += NGT) o[i] = pk2(sk[2 * i], sk[2 * i + 1]); }
    bf16_t* XN = (bf16_t*)(C.ws + WS_XN);
    for (int m = gw; m < T; m += NGW) rms_row_to_bf16(C.in(I_X) + (size_t)m * D, C.in(I_MIXNW), XN + (size_t)m * D, C.lane);
}

__device__ __forceinline__ void unpack8(const u32x4 v, float (&f)[8]) { f[0] = bflo(v.x); f[1] = bfhi(v.x); f[2] = bflo(v.y); f[3] = bfhi(v.y); f[4] = bflo(v.z); f[5] = bfhi(v.z); f[6] = bflo(v.w); f[7] = bfhi(v.w); }
struct EpiProj {
    static constexpr bool PERM = true, AFTER_DRAIN = false; static constexpr bool TWO_PASS = false;
    unsigned char* ws; const float* gate_b; int hh;
    __device__ __forceinline__ void operator()(const f32x4 (&acc)[2][2][4][2], const Unit& u, int wr, int wc, int fr, int fq) const {
        { int z_ = 0; asm volatile("" : "+v"(z_)); fr += z_; }
        const int pn = u.pn, row0 = u.pm * 256 + wr * 64 + fr, cin = wc * 32 + 8 * fq;
        if (pn >= 104) {
            float* S = (float*)(ws + WS_SMALL);
#pragma unroll
            for (int ai = 0; ai < 2; ++ai)
#pragma unroll
                for (int m = 0; m < 4; ++m) { float* rowp = S + (size_t)(row0 + ai * 128 + m * 16) * 128 + cin;
                    *(f32x4*)(rowp) = acc[ai][0][m][0]; *(f32x4*)(rowp + 4) = acc[ai][0][m][1]; }
            return;
        }
        bf16_t* base; int ldc, colt; bf16_t* halo = nullptr; bool gate = false;
        if (pn < 16) { base = (bf16_t*)(ws + WS_ZSSM); ldc = 4096; colt = pn * 256; }
        else if (pn < 40) { base = (bf16_t*)(ws + WS_XBC); ldc = 6144; colt = (pn - 16) * 256; halo = (bf16_t*)(ws + WS_HALO_XBC); }
        else if (pn < 72) { base = (bf16_t*)(ws + WS_QKV); ldc = 8192; colt = (pn - 40) * 256; halo = (bf16_t*)(ws + WS_HALO_QKV); }
        else if (pn < 88) { base = (bf16_t*)(ws + WS_ZGDN); ldc = 4096; colt = (pn - 72) * 256; }
        else { base = (bf16_t*)(ws + WS_GATES); ldc = 4096; colt = (pn - 88) * 256; gate = true; }
        const int col0 = colt + cin;
        f32x4 bv[2][2];
#pragma unroll
        for (int bj = 0; bj < 2; ++bj)
#pragma unroll
            for (int n = 0; n < 2; ++n) bv[bj][n] = gate ? *(const f32x4*)(gate_b + col0 + bj * 128 + 4 * n) : (f32x4){0.f, 0.f, 0.f, 0.f};
#pragma unroll
        for (int ai = 0; ai < 2; ++ai)
#pragma unroll
            for (int m = 0; m < 4; ++m) { const int r = row0 + ai * 128 + m * 16; bf16_t* rowp = base + (size_t)r * ldc + col0;
#pragma unroll
                for (int bj = 0; bj < 2; ++bj) { f32x4 v0 = acc[ai][bj][m][0] + bv[bj][0], v1 = acc[ai][bj][m][1] + bv[bj][1];
                    if (gate) {
#pragma unroll
                        for (int e = 0; e < 4; ++e) { v0[e] = sigmoidf_(v0[e]); v1[e] = sigmoidf_(v1[e]); } }
                    u32x4 w; w.x = cvt_pk_bf16(v0[0], v0[1]); w.y = cvt_pk_bf16(v0[2], v0[3]); w.z = cvt_pk_bf16(v1[0], v1[1]); w.w = cvt_pk_bf16(v1[2], v1[3]);
                    *(u32x4*)(rowp + bj * 128) = w;
                    if (halo != nullptr && m == 3 && fr >= 13) {
                        const int gc = hh * 128 + (r >> 6);
                        *(u32x4*)(halo + (size_t)(gc * 3 + (fr - 13)) * ldc + col0 + bj * 128) = w; }
                } }
    }
};
struct EpiSmall {
    static constexpr bool PERM = true, AFTER_DRAIN = false; static constexpr bool TWO_PASS = false;
    float* S;
    __device__ __forceinline__ void operator()(const f32x4 (&acc)[2][2][4][2], const Unit& u, int wr, int wc, int fr, int fq) const {
        { int z_ = 0; asm volatile("" : "+v"(z_)); fr += z_; }
        const int row0 = u.pm * 256 + wr * 64 + fr, cin = wc * 32 + 8 * fq;
#pragma unroll
        for (int ai = 0; ai < 2; ++ai)
#pragma unroll
            for (int m = 0; m < 4; ++m) { float* rowp = S + (size_t)(row0 + ai * 128 + m * 16) * 128 + cin;
                *(f32x4*)(rowp) = acc[ai][0][m][0]; *(f32x4*)(rowp + 4) = acc[ai][0][m][1]; }
    }
};
template <int WHICH> struct EpiMix {
    static constexpr bool PERM = true, AFTER_DRAIN = false; static constexpr bool TWO_PASS = false;
    unsigned char* ws;
    __device__ __forceinline__ void operator()(const f32x4 (&acc)[2][2][4][2], const Unit& u, int wr, int wc, int fr, int fq) const {
        { int z_ = 0; asm volatile("" : "+v"(z_)); fr += z_; }
        const int row0 = u.pm * 256 + wr * 64 + fr, col0 = u.pn * 256 + wc * 32 + 8 * fq;
        const bf16_t* G = (const bf16_t*)(ws + WS_GATES) + WHICH * 2048; bf16_t* Mx = (bf16_t*)(ws + WS_MIXED);
#pragma unroll
        for (int ai = 0; ai < 2; ++ai)
#pragma unroll
            for (int m = 0; m < 4; ++m) { const int r = row0 + ai * 128 + m * 16;
#pragma unroll
                for (int bj = 0; bj < 2; ++bj) {
                    const u32x4 g = *(const u32x4*)(G + (size_t)r * 4096 + col0 + bj * 128);
                    f32x4 v0 = acc[ai][bj][m][0], v1 = acc[ai][bj][m][1];
                    v0[0] *= bflo(g.x); v0[1] *= bfhi(g.x); v0[2] *= bflo(g.y); v0[3] *= bfhi(g.y);
                    v1[0] *= bflo(g.z); v1[1] *= bfhi(g.z); v1[2] *= bflo(g.w); v1[3] *= bfhi(g.w);
                    u32x4* dst = (u32x4*)(Mx + (size_t)r * 2048 + col0 + bj * 128);
                    if (WHICH == 1) { const u32x4 p = *dst;
                        v0[0] += bflo(p.x); v0[1] += bfhi(p.x); v0[2] += bflo(p.y); v0[3] += bfhi(p.y);
                        v1[0] += bflo(p.z); v1[1] += bfhi(p.z); v1[2] += bflo(p.w); v1[3] += bfhi(p.w); }
                    u32x4 w; w.x = cvt_pk_bf16(v0[0], v0[1]); w.y = cvt_pk_bf16(v0[2], v0[3]); w.z = cvt_pk_bf16(v1[0], v1[1]); w.w = cvt_pk_bf16(v1[2], v1[3]);
                    *dst = w; }
                asm volatile("" ::: "memory"); }
    }
};
struct EpiMixF {
    static constexpr bool PERM = true, AFTER_DRAIN = false; static constexpr bool TWO_PASS = true;
    unsigned char* ws;
    __device__ __forceinline__ void mid(f32x4 (&acc)[2][2][4][2], const Unit& u, int wr, int wc, int fr, int fq) const {
        { int z_ = 0; asm volatile("" : "+v"(z_)); fr += z_; }
        const int row0 = u.pm * 256 + wr * 64 + fr, col0 = u.pn * 256 + wc * 32 + 8 * fq;
        const bf16_t* G = (const bf16_t*)(ws + WS_GATES);
#pragma unroll
        for (int ai = 0; ai < 2; ++ai)
#pragma unroll
            for (int m = 0; m < 4; ++m) { const int r = row0 + ai * 128 + m * 16;
#pragma unroll
                for (int bj = 0; bj < 2; ++bj) {
                    const u32x4 gs = *(const u32x4*)(G + (size_t)r * 4096 + col0 + bj * 128), gg = *(const u32x4*)(G + (size_t)r * 4096 + 2048 + col0 + bj * 128);
                    float s_[8], g_[8]; unpack8(gs, s_); unpack8(gg, g_);
#pragma unroll
                    for (int e = 0; e < 4; ++e) { acc[ai][bj][m][0][e] *= s_[e] * __builtin_amdgcn_rcpf(fmaxf(g_[e], 1e-30f)); acc[ai][bj][m][1][e] *= s_[4 + e] * __builtin_amdgcn_rcpf(fmaxf(g_[4 + e], 1e-30f)); } }
                asm volatile("" ::: "memory"); }
    }
    __device__ __forceinline__ void operator()(const f32x4 (&acc)[2][2][4][2], const Unit& u, int wr, int wc, int fr, int fq) const {
        { int z_ = 0; asm volatile("" : "+v"(z_)); fr += z_; }
        const int row0 = u.pm * 256 + wr * 64 + fr, col0 = u.pn * 256 + wc * 32 + 8 * fq;
        const bf16_t* G = (const bf16_t*)(ws + WS_GATES) + 2048; bf16_t* Mx = (bf16_t*)(ws + WS_MIXED);
#pragma unroll
        for (int ai = 0; ai < 2; ++ai)
#pragma unroll
            for (int m = 0; m < 4; ++m) { const int r = row0 + ai * 128 + m * 16;
#pragma unroll
                for (int bj = 0; bj < 2; ++bj) {
                    const u32x4 gg = *(const u32x4*)(G + (size_t)r * 4096 + col0 + bj * 128); float g_[8]; unpack8(gg, g_);
                    f32x4 v0 = acc[ai][bj][m][0], v1 = acc[ai][bj][m][1];
#pragma unroll
                    for (int e = 0; e < 4; ++e) { v0[e] *= fmaxf(g_[e], 1e-30f); v1[e] *= fmaxf(g_[4 + e], 1e-30f); }
                    *(u32x4*)(Mx + (size_t)r * 2048 + col0 + bj * 128) = (u32x4){pkc(v0[0], v0[1]), pkc(v0[2], v0[3]), pkc(v1[0], v1[1]), pkc(v1[2], v1[3])}; }
                asm volatile("" ::: "memory"); }
    }
};
struct EpiOut {
    static constexpr bool PERM = true, AFTER_DRAIN = false; static constexpr bool TWO_PASS = false;
    const float* x; bf16_t* hb; float* ssq;
    __device__ __forceinline__ void operator()(const f32x4 (&acc)[2][2][4][2], const Unit& u, int wr, int wc, int fr, int fq) const {
        { int z_ = 0; asm volatile("" : "+v"(z_)); fr += z_; }
        const int row0 = u.pm * 256 + wr * 64 + fr, col0 = u.pn * 256 + wc * 32 + 8 * fq;
#pragma unroll
        for (int ai = 0; ai < 2; ++ai)
#pragma unroll
            for (int m = 0; m < 4; ++m) { const int r = row0 + ai * 128 + m * 16; const size_t off = (size_t)r * 2048 + col0; float ss = 0.f;
#pragma unroll
                for (int bj = 0; bj < 2; ++bj) { const f32x4 v0 = *(const f32x4*)(x + off + bj * 128) + acc[ai][bj][m][0], v1 = *(const f32x4*)(x + off + bj * 128 + 4) + acc[ai][bj][m][1];
                    ss += (v0[0] * v0[0] + v0[1] * v0[1]) + (v0[2] * v0[2] + v0[3] * v0[3]) + (v1[0] * v1[0] + v1[1] * v1[1]) + (v1[2] * v1[2] + v1[3] * v1[3]);
                    *(u32x4*)(hb + off + bj * 128) = (u32x4){pkc(v0[0], v0[1]), pkc(v0[2], v0[3]), pkc(v1[0], v1[1]), pkc(v1[2], v1[3])}; }
                ss += __shfl_xor(ss, 16); ss += __shfl_xor(ss, 32);
                if (fq == 0) ssq[(size_t)r * 32 + u.pn * 4 + wc] = ss;
                asm volatile("" ::: "memory"); }
    }
};
struct EpiQ {
    static constexpr bool PERM = true, AFTER_DRAIN = false; static constexpr bool TWO_PASS = false;
    bf16_t* O;
    __device__ __forceinline__ void operator()(const f32x4 (&acc)[2][2][4][2], const Unit& u, int wr, int wc, int fr, int fq) const {
        { int z_ = 0; asm volatile("" : "+v"(z_)); fr += z_; }
        const int row0 = u.pm * 256 + wr * 64 + fr, col0 = u.pn * 256 + wc * 32 + 8 * fq;
#pragma unroll
        for (int ai = 0; ai < 2; ++ai)
#pragma unroll
            for (int m = 0; m < 4; ++m) { bf16_t* rowp = O + (size_t)(row0 + ai * 128 + m * 16) * 2048 + col0;
#pragma unroll
                for (int bj = 0; bj < 2; ++bj) { const f32x4 v0 = acc[ai][bj][m][0], v1 = acc[ai][bj][m][1];
                    u32x4 w; w.x = pkc(v0[0], v0[1]); w.y = pkc(v0[2], v0[3]); w.z = pkc(v1[0], v1[1]); w.w = pkc(v1[2], v1[3]);
                    *(u32x4*)(rowp + bj * 128) = w; } }
    }
};

constexpr int TB = 32;
__device__ __forceinline__ float raw_at(const bf16_t* buf, const bf16_t* halo, int ld, int hh, int tl, int col) {
    if (tl >= 0) return bf2f(buf[(size_t)tl * ld + col]);
    if (hh == 0) return 0.f;
    return bf2f(halo[(size_t)((hh * 128 - 1) * 3 + (tl + 3)) * ld + col]);
}
__device__ __forceinline__ void ssd_naive(const Ctx& C, int hh, int g) {
    bf16_t* XBC = (bf16_t*)(C.ws + WS_XBC); const bf16_t* HALO = (const bf16_t*)(C.ws + WS_HALO_XBC);
    const float* SM = (const float*)(C.ws + WS_SMALLF) + (size_t)hh * TH * 128;
    LAS float* Bs = (LAS float*)C.lds; LAS float* Cs = Bs + TB * 128; LAS float* Xs = Cs + TB * 128; LAS float* dts = Xs + TB * 512; LAS float* dAs = dts + TB * 8;
    const int tid = C.tid, r = C.wave, p = C.lane, head = g * 8 + r, xcol = head * 64 + p;
    const int bccol = (tid < 128) ? (4096 + g * 128 + tid) : (5120 + g * 128 + ((tid - 128) & 127));
    const float* cw = C.in(I_SCW); const float* cb = C.in(I_SCB);
    const float xw0 = cw[xcol], xw1 = cw[6144 + xcol], xw2 = cw[2 * 6144 + xcol], xw3 = cw[3 * 6144 + xcol], xb = cb[xcol];
    const float bw0 = cw[bccol], bw1 = cw[6144 + bccol], bw2 = cw[2 * 6144 + bccol], bw3 = cw[3 * 6144 + bccol], bb = cb[bccol];
    float x0 = raw_at(XBC, HALO, 6144, hh, -3, xcol), x1 = raw_at(XBC, HALO, 6144, hh, -2, xcol), x2 = raw_at(XBC, HALO, 6144, hh, -1, xcol);
    float b0 = raw_at(XBC, HALO, 6144, hh, -3, bccol), b1 = raw_at(XBC, HALO, 6144, hh, -2, bccol), b2 = raw_at(XBC, HALO, 6144, hh, -1, bccol);
    const float Dh = C.in(I_SD)[head];
    float* stp = (float*)(C.ws + WS_ST_SSD) + (size_t)(head * 64 + p) * 128;
    f32x4 h[32];
#pragma unroll
    for (int j = 0; j < 32; ++j) h[j] = *(const f32x4*)(stp + 4 * j);
    for (int t0 = 0; t0 < TH; t0 += TB) {
#pragma unroll 4
        for (int s = 0; s < TB; ++s) {
            const float rb = bf2f(XBC[(size_t)(t0 + s) * 6144 + bccol]);
            const float vb = siluf_(bw0 * b0 + bw1 * b1 + bw2 * b2 + bw3 * rb + bb); b0 = b1; b1 = b2; b2 = rb;
            if (tid < 128) Bs[s * 128 + tid] = vb; else if (tid < 256) Cs[s * 128 + (tid - 128)] = vb;
            const float rx = bf2f(XBC[(size_t)(t0 + s) * 6144 + xcol]);
            const float vx = siluf_(xw0 * x0 + xw1 * x1 + xw2 * x2 + xw3 * rx + xb); x0 = x1; x1 = x2; x2 = rx;
            Xs[s * 512 + tid] = vx;
        }
        if (tid < TB * 8) { const int s = tid >> 3, rr = tid & 7, hd = g * 8 + rr;
            const float dtv = softplusf_(SM[(size_t)(t0 + s) * 128 + hd] + C.in(I_SDTB)[hd]);
            dts[s * 8 + rr] = dtv; dAs[s * 8 + rr] = __expf(-__expf(C.in(I_SALOG)[hd]) * dtv); }
        __syncthreads();
#pragma unroll 1
        for (int s = 0; s < TB; ++s) {
            const float xv = Xs[s * 512 + tid], dt = dts[s * 8 + r], dA = dAs[s * 8 + r], xdt = xv * dt;
            float y = 0.f;
#pragma unroll
            for (int j = 0; j < 32; ++j) { const f32x4 bq = *(const LAS f32x4*)(Bs + s * 128 + 4 * j), cq = *(const LAS f32x4*)(Cs + s * 128 + 4 * j);
                h[j] = h[j] * dA + xdt * bq; y += (h[j].x * cq.x + h[j].y * cq.y) + (h[j].z * cq.z + h[j].w * cq.w);
                if ((j & 3) == 3) asm volatile("" ::: "memory"); }
            XBC[(size_t)(t0 + s) * 6144 + xcol] = (bf16_t)f2bf(y + xv * Dh);
        }
        __syncthreads();
    }
#pragma unroll
    for (int j = 0; j < 32; ++j) *(f32x4*)(stp + 4 * j) = h[j];
}
__device__ __forceinline__ void gdn_naive(const Ctx& C, int hh, int head) {
    bf16_t* QKV = (bf16_t*)(C.ws + WS_QKV); const bf16_t* HALO = (const bf16_t*)(C.ws + WS_HALO_QKV);
    const float* SM = (const float*)(C.ws + WS_SMALLF) + (size_t)hh * TH * 128;
    LAS float* qs = (LAS float*)C.lds; LAS float* ks = qs + TB * 128; LAS float* vs = ks + TB * 128; LAS float* bts = vs + TB * 256; LAS float* gs = bts + TB;
    const int tid = C.tid, lane = C.lane, wave = C.wave;
    const int ccol = (tid < 128) ? (head * 128 + tid) : (tid < 256 ? (2048 + head * 128 + (tid - 128)) : (4096 + head * 256 + (tid - 256)));
    const float* cw = C.in(I_GCW);
    const float w0 = cw[ccol], w1 = cw[8192 + ccol], w2 = cw[2 * 8192 + ccol], w3 = cw[3 * 8192 + ccol];
    float r0 = raw_at(QKV, HALO, 8192, hh, -3, ccol), r1 = raw_at(QKV, HALO, 8192, hh, -2, ccol), r2 = raw_at(QKV, HALO, 8192, hh, -1, ccol);
    const float aneg = -__expf(C.in(I_GALOG)[head]), dtb = C.in(I_GDTB)[head];
    const int c = tid & 255;
    float* stp = (float*)(C.ws + WS_ST_GDN) + (size_t)(head * 256 + c) * 128;
    f32x4 S[32];
    if (tid < 256) {
#pragma unroll
        for (int j = 0; j < 32; ++j) S[j] = *(const f32x4*)(stp + 4 * j);
    }
    for (int t0 = 0; t0 < TH; t0 += TB) {
#pragma unroll 4
        for (int s = 0; s < TB; ++s) {
            const float rw = bf2f(QKV[(size_t)(t0 + s) * 8192 + ccol]);
            const float v = siluf_(w0 * r0 + w1 * r1 + w2 * r2 + w3 * rw); r0 = r1; r1 = r2; r2 = rw;
            if (tid < 128) qs[s * 128 + tid] = v; else if (tid < 256) ks[s * 128 + (tid - 128)] = v; else vs[s * 256 + (tid - 256)] = v;
        }
        if (tid < TB) { bts[tid] = sigmoidf_(SM[(size_t)(t0 + tid) * 128 + 64 + head]);
            gs[tid] = __expf(aneg * softplusf_(SM[(size_t)(t0 + tid) * 128 + 80 + head] + dtb)); }
        __syncthreads();
        for (int row = wave; row < 2 * TB; row += 8) { LAS float* rp = (row < TB) ? (qs + row * 128) : (ks + (row - TB) * 128);
            const float a = rp[lane], b = rp[lane + 64]; const float ss = wave_sum(a * a + b * b);
            const float sc = rsqrtf(ss + EPS) * ((row < TB) ? 0.08838834764831845f : 1.0f);
            rp[lane] = a * sc; rp[lane + 64] = b * sc; }
        __syncthreads();
        if (tid < 256) {
#pragma unroll 1
            for (int s = 0; s < TB; ++s) {
                const float a = gs[s], bt = bts[s], v = vs[s * 256 + c];
                float dot = 0.f;
#pragma unroll
                for (int j = 0; j < 32; ++j) { const f32x4 kq = *(const LAS f32x4*)(ks + s * 128 + 4 * j); dot += (S[j].x * kq.x + S[j].y * kq.y) + (S[j].z * kq.z + S[j].w * kq.w);
                    if ((j & 3) == 3) asm volatile("" ::: "memory"); }
                const float vn = bt * (v - a * dot);
                float o = 0.f;
#pragma unroll
                for (int j = 0; j < 32; ++j) { const f32x4 kq = *(const LAS f32x4*)(ks + s * 128 + 4 * j), qq = *(const LAS f32x4*)(qs + s * 128 + 4 * j);
                    S[j] = S[j] * a + kq * vn; o += (S[j].x * qq.x + S[j].y * qq.y) + (S[j].z * qq.z + S[j].w * qq.w);
                    if ((j & 3) == 3) asm volatile("" ::: "memory"); }
                QKV[(size_t)(t0 + s) * 8192 + 4096 + head * 256 + c] = (bf16_t)f2bf(o);
            }
        }
        __syncthreads();
    }
    if (tid < 256) {
#pragma unroll
        for (int j = 0; j < 32; ++j) *(f32x4*)(stp + 4 * j) = S[j];
    }
}


__device__ __forceinline__ u32x4 raw8_at(const bf16_t* buf, const bf16_t* halo, int ld, int hh, int lr, int col) {
    if (lr >= 0) return *(const u32x4*)(buf + (size_t)lr * ld + col);
    if (hh == 0) return (u32x4){0u, 0u, 0u, 0u};
    return *(const u32x4*)(halo + (size_t)((hh * 128 - 1) * 3 + (lr + 3)) * ld + col);
}
__device__ __forceinline__ void p2_bc_conv(const Ctx& C, int hh) {
    const bf16_t* XBC = (const bf16_t*)(C.ws + WS_XBC); const bf16_t* HALO = (const bf16_t*)(C.ws + WS_HALO_XBC); bf16_t* BC = (bf16_t*)(C.ws + WS_BCCONV);
    const float* cw = C.in(I_SCW); const float* cb = C.in(I_SCB);
    const int gt = C.bid * NTHREADS + C.tid, NGT = C.G * NTHREADS;
    for (int it = gt; it < (TH / 8) * 256; it += NGT) {
        const int cgp = it & 255, r0 = (it >> 8) * 8, col = 4096 + cgp * 8;
        float w[4][8], b[8];
#pragma unroll
        for (int k = 0; k < 4; ++k) { const f32x4 a = *(const f32x4*)(cw + k * 6144 + col), c2 = *(const f32x4*)(cw + k * 6144 + col + 4);
            w[k][0] = a.x; w[k][1] = a.y; w[k][2] = a.z; w[k][3] = a.w; w[k][4] = c2.x; w[k][5] = c2.y; w[k][6] = c2.z; w[k][7] = c2.w; }
        { const f32x4 a = *(const f32x4*)(cb + col), c2 = *(const f32x4*)(cb + col + 4); b[0] = a.x; b[1] = a.y; b[2] = a.z; b[3] = a.w; b[4] = c2.x; b[5] = c2.y; b[6] = c2.z; b[7] = c2.w; }
        u32x4 raw[11];
#pragma unroll
        for (int j = 0; j < 11; ++j) raw[j] = raw8_at(XBC, HALO, 6144, hh, r0 - 3 + j, col);
        float x0[8], x1[8], x2[8], x3[8];
        unpack8(raw[0], x0); unpack8(raw[1], x1); unpack8(raw[2], x2);
#pragma unroll
        for (int r = 0; r < 8; ++r) { unpack8(raw[3 + r], x3); float o[8];
#pragma unroll
            for (int e = 0; e < 8; ++e) { o[e] = siluf_(w[0][e] * x0[e] + w[1][e] * x1[e] + w[2][e] * x2[e] + w[3][e] * x3[e] + b[e]); x0[e] = x1[e]; x1[e] = x2[e]; x2[e] = x3[e]; }
            u32x4 ov; ov.x = pkc(o[0], o[1]); ov.y = pkc(o[2], o[3]); ov.z = pkc(o[4], o[5]); ov.w = pkc(o[6], o[7]);
            *(u32x4*)(BC + (size_t)(r0 + r) * 2048 + cgp * 8) = ov; }
    }
}

constexpr int SP = 136;
constexpr int SSD_CS = 0, SSD_BS = 128 * SP * 2, SSD_XT = 2 * 128 * SP * 2, SSD_XW = SSD_XT + 64 * SP * 2, SSD_HS = SSD_XW + 64 * SP * 2, SSD_F = SSD_HS + 2 * 64 * SP * 2;
static_assert(SSD_F + 2048 + 1280 <= LDS_CTL_OFF, "SSD LDS map");
#define MFMA16(F, S, A) __builtin_amdgcn_mfma_f32_16x16x32_bf16((F), (S), (A), 0, 0, 0)
typedef short s16x4 __attribute__((ext_vector_type(4)));
__device__ __forceinline__ bf16x8 cat44(const u32x2 a, const u32x2 b) { const u32x4 v = (u32x4){a.x, a.y, b.x, b.y}; return __builtin_bit_cast(bf16x8, v); }
__device__ __forceinline__ void ssd_chunked(const Ctx& C, int hh, int unit) {
    const int head = unit >> 1, ph = unit & 1;
    bf16_t* XBC = (bf16_t*)(C.ws + WS_XBC); const bf16_t* HALO = (const bf16_t*)(C.ws + WS_HALO_XBC); const bf16_t* BC = (const bf16_t*)(C.ws + WS_BCCONV);
    const float* SM = (const float*)(C.ws + WS_SMALLF) + (size_t)hh * TH * 128;
    LAS bf16_t* Cs = (LAS bf16_t*)(C.lds + SSD_CS); LAS bf16_t* Bs = (LAS bf16_t*)(C.lds + SSD_BS); LAS bf16_t* XsT = (LAS bf16_t*)(C.lds + SSD_XT);
    LAS bf16_t* XwT = (LAS bf16_t*)(C.lds + SSD_XW); LAS bf16_t* Hs = (LAS bf16_t*)(C.lds + SSD_HS);
    LAS float* avec = (LAS float*)(C.lds + SSD_F);
    LAS float* cwt = avec + 512;
    const int tid = C.tid, lane = C.lane, w = C.wave, i = lane & 15, g = lane >> 4, grp = head >> 3;
    const float aneg = -__expf(C.in(I_SALOG)[head]), dtb = C.in(I_SDTB)[head], Dh = C.in(I_SD)[head];
    const int cg = tid & 15, sr = tid >> 4, xcol = head * 64 + 32 * ph + cg * 2;
    if (tid < 160) { const int k = tid >> 5, c = tid & 31; cwt[tid] = (k < 4) ? C.in(I_SCW)[k * 6144 + head * 64 + 32 * ph + c] : C.in(I_SCB)[head * 64 + 32 * ph + c]; }
    float* stp = (float*)(C.ws + WS_ST_SSD) + (size_t)(head * 64 + 32 * ph) * 128;
    f32x4 hacc[2];
#pragma unroll
    for (int pt = 0; pt < 2; ++pt)
#pragma unroll
        for (int e = 0; e < 4; ++e) { const float v = stp[(16 * pt + 4 * g + e) * 128 + 16 * w + i]; hacc[pt][e] = v; Hs[(16 * pt + 4 * g + e) * SP + 16 * w + i] = (bf16_t)f2bf(v); }
    u32x4 pbc[8]; unsigned px[7]; float pdt0 = 0.f, pdt1 = 0.f;
#define SSD_PREFETCH(t0_) do { \
        _Pragma("unroll") for (int k = 0; k < 8; ++k) { const int q = tid + 512 * k, which = q >> 11, qq = q & 2047, row = qq >> 4, pc = qq & 15; \
            pbc[k] = *(const u32x4*)(BC + (size_t)((t0_) + row) * 2048 + which * 1024 + grp * 128 + pc * 8); } \
        { const int gc = hh * 128 + (t0_) / 64 - 1, gcs_ = gc < 0 ? 0 : gc; \
          _Pragma("unroll") for (int j = 0; j < 7; ++j) { const int lr = 4 * sr - 3 + j; \
            const bf16_t* pp = (j >= 3 || lr >= 0) ? (XBC + (size_t)((t0_) + (lr < 0 ? 0 : lr)) * 6144 + xcol) : (HALO + (size_t)(gcs_ * 3 + lr + 3) * 6144 + xcol); \
            px[j] = *(const unsigned*)pp; if (j < 3 && lr < 0 && gc < 0) px[j] = 0u; } } } while (0)
#define SSD_DTLOAD(t0_) do { if (tid < 64) { pdt0 = SM[(size_t)((t0_) + 2 * tid) * 128 + head]; pdt1 = SM[(size_t)((t0_) + 2 * tid + 1) * 128 + head]; } } while (0)
#define SSD_DTSCAN(b_) do { if (tid < 64) { const float d0 = softplusf_(pdt0 + dtb), d1 = softplusf_(pdt1 + dtb); const float a0 = d0 * aneg, a1 = d1 * aneg; \
            float s = a0 + a1; \
            _Pragma("unroll") for (int o = 1; o < 64; o <<= 1) { const float t = __shfl_up(s, o); if (lane >= o) s += t; } \
            LAS float* av_ = avec + (b_) * 256; av_[128 + 2 * lane] = d0; av_[128 + 2 * lane + 1] = d1; av_[2 * lane] = s - a1; av_[2 * lane + 1] = s; } } while (0)
    SSD_PREFETCH(0); SSD_DTLOAD(0); SSD_DTSCAN(0);
    if (128 < TH) SSD_DTLOAD(128);
    __syncthreads();
    const int tid0 = tid, lane0 = lane;
    for (int t0 = 0; t0 < TH; t0 += 128) {
        int tid = tid0, lane = lane0; asm volatile("" : "+v"(tid), "+v"(lane));
        const int i = lane & 15, g = lane >> 4, cg = tid & 15, sr = tid >> 4;
        const LAS float* acs = avec + ((t0 >> 7) & 1) * 256; const LAS float* dts = acs + 128;
        const LAS bf16_t* HsR = Hs + ((t0 >> 7) & 1) * (64 * SP); LAS bf16_t* HsW = Hs + (((t0 >> 7) + 1) & 1) * (64 * SP);
#pragma unroll
        for (int k = 0; k < 8; ++k) { const int q = tid + 512 * k, which = q >> 11, qq = q & 2047, row = qq >> 4, pc = qq & 15;
            *(LAS u32x4*)((which ? Cs : Bs) + row * SP + pc * 8) = pbc[k]; }
        { const float alast = acs[127]; const int rw = 4 * sr; float sc[4];
#pragma unroll
          for (int r = 0; r < 4; ++r) sc[r] = dts[rw + r] * __expf(alast - acs[rw + r]);
#pragma unroll
          for (int e = 0; e < 2; ++e) { const int c = cg * 2 + e; const float k0 = cwt[c], k1 = cwt[32 + c], k2 = cwt[64 + c], k3 = cwt[96 + c], kb = cwt[128 + c];
              float v[4];
#pragma unroll
              for (int r = 0; r < 4; ++r) { const float a0 = e ? bfhi(px[r]) : bflo(px[r]), a1 = e ? bfhi(px[r + 1]) : bflo(px[r + 1]), a2 = e ? bfhi(px[r + 2]) : bflo(px[r + 2]), a3 = e ? bfhi(px[r + 3]) : bflo(px[r + 3]);
                  v[r] = siluf_(k0 * a0 + k1 * a1 + k2 * a2 + k3 * a3 + kb); }
              *(LAS u32x2*)(XsT + c * SP + rw) = (u32x2){pkc(v[0], v[1]), pkc(v[2], v[3])};
              *(LAS u32x2*)(XwT + c * SP + rw) = (u32x2){pkc(v[0] * sc[0], v[1] * sc[1]), pkc(v[2] * sc[2], v[3] * sc[3])}; } }
        __syncthreads();
        if (t0 + 128 < TH) SSD_PREFETCH(t0 + 128);
        {
            const int lt = (w < 4) ? w : 11 - w;
            const int l = 16 * lt + i; const float acl = acs[l];
            bf16x8 cf[4], hq[8];
#pragma unroll
            for (int ks = 0; ks < 4; ++ks) cf[ks] = *(const LAS bf16x8*)(Cs + l * SP + 32 * ks + 8 * g);
            f32x4 yd[2];
#pragma unroll
            for (int pt = 0; pt < 2; ++pt) yd[pt] = (f32x4){0.f, 0.f, 0.f, 0.f};
#pragma unroll
            for (int ks = 0; ks < 4; ++ks)
#pragma unroll
                for (int pt = 0; pt < 2; ++pt) hq[ks * 2 + pt] = *(const LAS bf16x8*)(HsR + (16 * pt + i) * SP + 32 * ks + 8 * g);
            __builtin_amdgcn_sched_barrier(0);
#pragma unroll
            for (int ks = 0; ks < 4; ++ks)
#pragma unroll
                for (int pt = 0; pt < 2; ++pt) yd[pt] = MFMA16(hq[ks * 2 + pt], cf[ks], yd[pt]);
            { const float el = __expf(acl);
#pragma unroll
              for (int pt = 0; pt < 2; ++pt) yd[pt] = yd[pt] * el; }
#pragma unroll
            for (int j2 = 0; j2 < 4; ++j2) {
                if (2 * j2 <= lt) {
                    const bool two = (2 * j2 + 1 <= lt);
                    bf16x8 bq[8], xq[2];
#pragma unroll
                    for (int ks = 0; ks < 4; ++ks) { bq[ks] = *(const LAS bf16x8*)(Bs + (32 * j2 + i) * SP + 32 * ks + 8 * g); bq[4 + ks] = *(const LAS bf16x8*)(Bs + (32 * j2 + 16 + i) * SP + 32 * ks + 8 * g); }
#pragma unroll
                    for (int pt = 0; pt < 2; ++pt) xq[pt] = cat44(*(const LAS u32x2*)(XsT + (16 * pt + i) * SP + 32 * j2 + 4 * g), *(const LAS u32x2*)(XsT + (16 * pt + i) * SP + 32 * j2 + 16 + 4 * g));
                    const f32x4 a0 = *(const LAS f32x4*)(acs + 32 * j2 + 4 * g), a1 = *(const LAS f32x4*)(acs + 32 * j2 + 16 + 4 * g);
                    const f32x4 q0 = *(const LAS f32x4*)(dts + 32 * j2 + 4 * g), q1 = *(const LAS f32x4*)(dts + 32 * j2 + 16 + 4 * g);
                    __builtin_amdgcn_sched_barrier(0);
                    f32x4 d0 = (f32x4){0.f, 0.f, 0.f, 0.f}, d1 = (f32x4){0.f, 0.f, 0.f, 0.f};
#pragma unroll
                    for (int ks = 0; ks < 4; ++ks) { d0 = MFMA16(bq[ks], cf[ks], d0); if (two) d1 = MFMA16(bq[4 + ks], cf[ks], d1); }
                    float v0[4], v1[4];
#pragma unroll
                    for (int e = 0; e < 4; ++e) { const int s = 32 * j2 + 4 * g + e;
                        v0[e] = (s <= l) ? d0[e] * __expf(fminf(acl - a0[e], 0.f)) * q0[e] : 0.f;
                        v1[e] = (two && s + 16 <= l) ? d1[e] * __expf(fminf(acl - a1[e], 0.f)) * q1[e] : 0.f; }
                    const u32x4 sfu = (u32x4){pkc(v0[0], v0[1]), pkc(v0[2], v0[3]), pkc(v1[0], v1[1]), pkc(v1[2], v1[3])};
                    const bf16x8 sf = __builtin_bit_cast(bf16x8, sfu);
#pragma unroll
                    for (int pt = 0; pt < 2; ++pt) yd[pt] = MFMA16(xq[pt], sf, yd[pt]);
                }
            }
            if (t0 + 128 < TH) SSD_DTSCAN(((t0 >> 7) + 1) & 1);
#pragma unroll
            for (int pt = 0; pt < 2; ++pt) { float y[4];
#pragma unroll
                for (int e = 0; e < 4; ++e) { const float xv = bf2f(XsT[(16 * pt + 4 * g + e) * SP + l]); y[e] = yd[pt][e] + Dh * xv; }
                u32x2 ov; ov.x = pkc(y[0], y[1]); ov.y = pkc(y[2], y[3]);
                *(u32x2*)(XBC + (size_t)(t0 + l) * 6144 + head * 64 + 32 * ph + 16 * pt + 4 * g) = ov; }
            if (t0 + 256 < TH) SSD_DTLOAD(t0 + 256);
        }
        {
            const float ec = __expf(acs[127]);
#pragma unroll
            for (int pt = 0; pt < 2; ++pt) hacc[pt] = hacc[pt] * ec;
            const int q = (lane & 15) >> 2, p = lane & 3;
            s16x4 ta[4], tb[4]; bf16x8 xwq[8];
#pragma unroll
            for (int ks = 0; ks < 4; ++ks) {
                ta[ks] = __builtin_amdgcn_ds_read_tr16_b64_v4i16((LAS s16x4*)(Bs + (32 * ks + 8 * g + q) * SP + 16 * w + 4 * p));
                tb[ks] = __builtin_amdgcn_ds_read_tr16_b64_v4i16((LAS s16x4*)(Bs + (32 * ks + 8 * g + 4 + q) * SP + 16 * w + 4 * p));
#pragma unroll
                for (int pt = 0; pt < 2; ++pt) xwq[ks * 2 + pt] = *(const LAS bf16x8*)(XwT + (16 * pt + i) * SP + 32 * ks + 8 * g); }
            __builtin_amdgcn_sched_barrier(0);
#pragma unroll
            for (int ks = 0; ks < 4; ++ks) { const bf16x8 bt = (bf16x8){ta[ks][0], ta[ks][1], ta[ks][2], ta[ks][3], tb[ks][0], tb[ks][1], tb[ks][2], tb[ks][3]};
#pragma unroll
                for (int pt = 0; pt < 2; ++pt) hacc[pt] = MFMA16(xwq[ks * 2 + pt], bt, hacc[pt]); }
#pragma unroll
            for (int pt = 0; pt < 2; ++pt)
#pragma unroll
                for (int e = 0; e < 4; ++e) HsW[(16 * pt + 4 * g + e) * SP + 16 * w + i] = (bf16_t)f2bf(hacc[pt][e]);
        }
        __syncthreads();
    }
#undef SSD_PREFETCH
#undef SSD_DTLOAD
#undef SSD_DTSCAN
    { int l2 = lane; asm volatile("" : "+v"(l2));
      float* sp2 = stp + (4 * (l2 >> 4)) * 128 + 16 * w + (l2 & 15);
#pragma unroll
      for (int pt = 0; pt < 2; ++pt)
#pragma unroll
        for (int e = 0; e < 4; ++e) sp2[(16 * pt + e) * 128] = hacc[pt][e]; }
}

constexpr int SPK = 136, SPV = 264, SPT = 72, LMP = 68;
constexpr int GP_QN = 0, GP_KN = GP_QN + 64 * SPK * 2, GP_KB = GP_KN + 64 * SPK * 2, GP_VB = GP_KB + 64 * SPK * 2, GP_TI = GP_VB + 64 * SPV * 2, GP_LM = GP_TI + 64 * SPT * 2, GP_VEC = GP_LM + 64 * LMP * 4, GP_XI = GP_VEC + 1024;
static_assert(GP_XI + 64 * LMP * 4 <= LDS_CTL_OFF, "gdn_pre LDS map");
__device__ __forceinline__ void gdn_pre(const Ctx& C, int hh) {
    bf16_t* QKV = (bf16_t*)(C.ws + WS_QKV); const bf16_t* HALO = (const bf16_t*)(C.ws + WS_HALO_QKV); const float* SM = (const float*)(C.ws + WS_SMALLF) + (size_t)hh * TH * 128;
    bf16_t* GW = (bf16_t*)(C.ws + WS_GW); bf16_t* GATT = (bf16_t*)(C.ws + WS_GATT); float* GCD = (float*)(C.ws + WS_GCD);
    LAS bf16_t* QN = (LAS bf16_t*)(C.lds + GP_QN); LAS bf16_t* KN = (LAS bf16_t*)(C.lds + GP_KN); LAS bf16_t* KB = (LAS bf16_t*)(C.lds + GP_KB); LAS bf16_t* VB = (LAS bf16_t*)(C.lds + GP_VB);
    LAS bf16_t* TI = (LAS bf16_t*)(C.lds + GP_TI); LAS float* LM = (LAS float*)(C.lds + GP_LM); LAS float* gcs = (LAS float*)(C.lds + GP_VEC); LAS float* bts = gcs + 64; LAS float* egs = bts + 64; LAS float* XI = (LAS float*)(C.lds + GP_XI);
    const float* cw = C.in(I_GCW);
    for (int item = C.bid; item < 2048; item += C.G) {
        int lane = C.lane, w = C.wave; asm volatile("" : "+v"(lane), "+s"(w));
        const int ii = lane & 15, g = lane >> 4;
        const int c = item >> 4, h = item & 15, t0 = c * 64;
        const float aneg = -__expf(C.in(I_GALOG)[h]), dtb = C.in(I_GDTB)[h];
        if (w == 0) { const float bt = sigmoidf_(SM[(size_t)(t0 + lane) * 128 + 64 + h]); float s = aneg * softplusf_(SM[(size_t)(t0 + lane) * 128 + 80 + h] + dtb);
#pragma unroll
            for (int o = 1; o < 64; o <<= 1) { const float t = __shfl_up(s, o); if (lane >= o) s += t; }
            gcs[lane] = s; bts[lane] = bt; egs[lane] = __expf(s); if (lane == 63) GCD[item] = __expf(s); }
        const int cgp = lane, sr = w;
        const int col = (cgp < 16) ? (h * 128 + cgp * 8) : (cgp < 32 ? (2048 + h * 128 + (cgp - 16) * 8) : (4096 + h * 256 + (cgp - 32) * 8));
        float o[8][8];
        { u32x4 raw[11];
#pragma unroll
          for (int j = 0; j < 11; ++j) { const int lr = 8 * sr - 3 + j;
              if (lr >= 0) raw[j] = *(const u32x4*)(QKV + (size_t)(t0 + lr) * 8192 + col);
              else { const int gc = hh * 128 + c - 1; raw[j] = gc < 0 ? (u32x4){0u, 0u, 0u, 0u} : *(const u32x4*)(HALO + (size_t)(gc * 3 + lr + 3) * 8192 + col); } }
          float wk[4][8];
#pragma unroll
          for (int k = 0; k < 4; ++k) { const f32x4 a = *(const f32x4*)(cw + k * 8192 + col), b = *(const f32x4*)(cw + k * 8192 + col + 4);
              wk[k][0] = a.x; wk[k][1] = a.y; wk[k][2] = a.z; wk[k][3] = a.w; wk[k][4] = b.x; wk[k][5] = b.y; wk[k][6] = b.z; wk[k][7] = b.w; }
          float x0[8], x1[8], x2[8], x3[8]; unpack8(raw[0], x0); unpack8(raw[1], x1); unpack8(raw[2], x2);
#pragma unroll
          for (int r = 0; r < 8; ++r) { unpack8(raw[3 + r], x3);
#pragma unroll
              for (int e = 0; e < 8; ++e) { o[r][e] = siluf_(wk[0][e] * x0[e] + wk[1][e] * x1[e] + wk[2][e] * x2[e] + wk[3][e] * x3[e]); x0[e] = x1[e]; x1[e] = x2[e]; x2[e] = x3[e]; } } }
        asm volatile("s_waitcnt vmcnt(0)" ::: "memory");
        __syncthreads();
        { const float glast = gcs[63];
#pragma unroll
          for (int r = 0; r < 8; ++r) { const int row = 8 * sr + r; float ss = 0.f;
#pragma unroll
              for (int e = 0; e < 8; ++e) ss += o[r][e] * o[r][e];
              ss += __shfl_xor(ss, 1); ss += __shfl_xor(ss, 2); ss += __shfl_xor(ss, 4); ss += __shfl_xor(ss, 8);
              const float bt = bts[row], eg = egs[row];
              float sc = (cgp < 32) ? rsqrtf(ss + EPS) : bt; if (cgp < 16) sc *= 0.08838834764831845f;
#pragma unroll
              for (int e = 0; e < 8; ++e) o[r][e] *= sc;
              const u32x4 pv = (u32x4){pkc(o[r][0], o[r][1]), pkc(o[r][2], o[r][3]), pkc(o[r][4], o[r][5]), pkc(o[r][6], o[r][7])};
              if (cgp < 16) { *(LAS u32x4*)(QN + row * SPK + cgp * 8) = pv;
                  { bf16_t* qp = QKV + (size_t)(t0 + row) * 8192 + h * 128 + 32 * (cgp >> 2) + 16 * (cgp & 1) + 4 * ((cgp >> 1) & 1);
                    *(u32x2*)qp = (u32x2){pkc(o[r][0] * eg, o[r][1] * eg), pkc(o[r][2] * eg, o[r][3] * eg)}; *(u32x2*)(qp + 8) = (u32x2){pkc(o[r][4] * eg, o[r][5] * eg), pkc(o[r][6] * eg, o[r][7] * eg)}; } }
              else if (cgp < 32) { *(LAS u32x4*)(KN + row * SPK + (cgp - 16) * 8) = pv; const float s2 = bt * eg;
                  *(LAS u32x4*)(KB + row * SPK + (cgp - 16) * 8) = (u32x4){pkc(o[r][0] * s2, o[r][1] * s2), pkc(o[r][2] * s2, o[r][3] * s2), pkc(o[r][4] * s2, o[r][5] * s2), pkc(o[r][6] * s2, o[r][7] * s2)}; }
              else *(LAS u32x4*)(VB + row * SPV + (cgp - 32) * 8) = pv; }
          if (cgp >= 16 && cgp < 32) { float kd[8];
#pragma unroll
              for (int r = 0; r < 8; ++r) kd[r] = __expf(glast - gcs[8 * sr + r]);
#pragma unroll
              for (int e = 0; e < 8; ++e) { const int dk = (cgp - 16) * 8 + e;
                  bf16_t* kp = QKV + (size_t)(t0 + (dk >> 1)) * 8192 + 2048 + h * 128 + (dk & 1) * 64 + 32 * (sr >> 2) + 16 * (sr & 1) + 4 * ((sr >> 1) & 1);
                  *(u32x2*)kp = (u32x2){pkc(o[0][e] * kd[0], o[1][e] * kd[1]), pkc(o[2][e] * kd[2], o[3][e] * kd[3])}; *(u32x2*)(kp + 8) = (u32x2){pkc(o[4][e] * kd[4], o[5][e] * kd[5]), pkc(o[6][e] * kd[6], o[7][e] * kd[7])}; } } }
        __syncthreads();
        { const int which = w >> 2, it = w & 3, i = 16 * it + ii; LAS bf16_t* SX = which ? QN : KN;
          bf16x8 sf[4];
#pragma unroll
          for (int ks = 0; ks < 4; ++ks) sf[ks] = *(const LAS bf16x8*)(SX + i * SPK + 32 * ks + 8 * g);
          const float gi = gcs[i], bi = bts[i];
#pragma unroll
          for (int jt = 0; jt < 4; ++jt) { f32x4 d = (f32x4){0.f, 0.f, 0.f, 0.f};
              if (jt <= it) {
#pragma unroll
                  for (int ks = 0; ks < 4; ++ks) d = MFMA16(*(const LAS bf16x8*)(KN + (16 * jt + ii) * SPK + 32 * ks + 8 * g), sf[ks], d); }
              const f32x4 gj = *(const LAS f32x4*)(gcs + 16 * jt + 4 * g); float v[4];
#pragma unroll
              for (int e = 0; e < 4; ++e) { const int j = 16 * jt + 4 * g + e; const float dec = __expf(fminf(gi - gj[e], 0.f));
                  v[e] = which ? ((j <= i) ? d[e] * dec : 0.f) : ((j < i) ? d[e] * bi * dec : 0.f); }
              if (which) *(u32x2*)(GATT + (size_t)item * 4096 + i * 64 + 32 * (jt >> 1) + 8 * g + 4 * (jt & 1)) = (u32x2){pkc(v[0], v[1]), pkc(v[2], v[3])};
              else *(LAS f32x4*)(LM + i * LMP + 16 * jt + 4 * g) = (f32x4){v[0], v[1], v[2], v[3]}; } }
        __syncthreads();
        { const int c16 = lane & 15, kg = lane >> 4;
          if (w < 4) { const int b0 = 16 * w; float Xd[16];
#pragma unroll
              for (int r = 0; r < 16; ++r) { float a0 = (r == 0 ? 0.f : 0.f); a0 = fmaxf(1.0f - fabsf((float)c16 - (float)r), 0.f); float a1 = 0.f;
#pragma unroll
                  for (int m = 0; m < r; ++m) { const float lv = LM[(b0 + r) * LMP + b0 + m]; if (m & 1) a1 -= lv * Xd[m]; else a0 -= lv * Xd[m]; }
                  Xd[r] = a0 + a1; }
#pragma unroll
              for (int r = 0; r < 16; ++r) if (kg == 0) XI[(b0 + r) * LMP + b0 + c16] = Xd[r]; }
          __syncthreads();
#pragma unroll
          for (int d = 1; d <= 3; ++d) {
              if (w + d <= 3) { const int bi = w + d, bj = w; f32x4 M = (f32x4){0.f, 0.f, 0.f, 0.f};
#pragma unroll
                  for (int mm = 0; mm < d; ++mm) { const int bm = bj + mm;
#pragma unroll
                      for (int st = 0; st < 4; ++st) M = __builtin_amdgcn_mfma_f32_16x16x4f32(LM[(16 * bi + c16) * LMP + 16 * bm + 4 * st + kg], XI[(16 * bm + 4 * st + kg) * LMP + 16 * bj + c16], M, 0, 0, 0); }
                  f32x4 R = (f32x4){0.f, 0.f, 0.f, 0.f};
#pragma unroll
                  for (int e = 0; e < 4; ++e) R = __builtin_amdgcn_mfma_f32_16x16x4f32(XI[(16 * bi + c16) * LMP + 16 * bi + 4 * kg + e], M[e], R, 0, 0, 0);
#pragma unroll
                  for (int e = 0; e < 4; ++e) XI[(16 * bi + 4 * kg + e) * LMP + 16 * bj + c16] = -R[e]; }
              __syncthreads(); }
          { const int tid2 = w * 64 + lane, i = tid2 >> 3, c0 = (tid2 & 7) * 8; float xv[8];
#pragma unroll
            for (int e = 0; e < 8; ++e) xv[e] = ((c0 >> 4) <= (i >> 4)) ? XI[i * LMP + c0 + e] : 0.f;
            *(LAS u32x4*)(TI + i * SPT + c0) = (u32x4){pkc(xv[0], xv[1]), pkc(xv[2], xv[3]), pkc(xv[4], xv[5]), pkc(xv[6], xv[7])}; } }
        __syncthreads();
        { const int it = w & 3, hf = w >> 2, q = (lane & 15) >> 2, p = lane & 3;
          bf16x8 tf[2];
#pragma unroll
          for (int ks = 0; ks < 2; ++ks) tf[ks] = *(const LAS bf16x8*)(TI + (16 * it + ii) * SPT + 32 * ks + 8 * g);
#pragma unroll
          for (int d8 = 0; d8 < 8; ++d8) { const int dt = 8 * hf + d8; f32x4 acc = (f32x4){0.f, 0.f, 0.f, 0.f};
#pragma unroll
              for (int ks = 0; ks < 2; ++ks) {
                  const s16x4 ta = __builtin_amdgcn_ds_read_tr16_b64_v4i16((LAS s16x4*)(VB + (32 * ks + 8 * g + q) * SPV + 16 * dt + 4 * p));
                  const s16x4 tb = __builtin_amdgcn_ds_read_tr16_b64_v4i16((LAS s16x4*)(VB + (32 * ks + 8 * g + 4 + q) * SPV + 16 * dt + 4 * p));
                  acc = MFMA16(tf[ks], ((bf16x8){ta[0], ta[1], ta[2], ta[3], tb[0], tb[1], tb[2], tb[3]}), acc); }
              const int dv = 16 * dt + ii;
              *(u32x2*)(QKV + (size_t)(t0 + (dv >> 2)) * 8192 + 4096 + h * 256 + (dv & 3) * 64 + 16 * it + 4 * g) = (u32x2){pkc(acc[0], acc[1]), pkc(acc[2], acc[3])}; }
#pragma unroll
          for (int k4 = 0; k4 < 4; ++k4) { const int kt = 4 * hf + k4; f32x4 acc = (f32x4){0.f, 0.f, 0.f, 0.f};
#pragma unroll
              for (int ks = 0; ks < 2; ++ks) {
                  const s16x4 ta = __builtin_amdgcn_ds_read_tr16_b64_v4i16((LAS s16x4*)(KB + (32 * ks + 8 * g + q) * SPK + 16 * kt + 4 * p));
                  const s16x4 tb = __builtin_amdgcn_ds_read_tr16_b64_v4i16((LAS s16x4*)(KB + (32 * ks + 8 * g + 4 + q) * SPK + 16 * kt + 4 * p));
                  acc = MFMA16(((bf16x8){ta[0], ta[1], ta[2], ta[3], tb[0], tb[1], tb[2], tb[3]}), tf[ks], acc); }
              *(u32x2*)(GW + (size_t)item * 8192 + (16 * it + ii) * 128 + 32 * (kt >> 1) + 8 * g + 4 * (kt & 1)) = (u32x2){pkc(acc[0], acc[1]), pkc(acc[2], acc[3])}; } }
        __syncthreads();
    }
}

#define MFMA32(F, S, A) __builtin_amdgcn_mfma_f32_32x32x16_bf16((F), (S), (A), 0, 0, 0)
typedef float f32x16 __attribute__((ext_vector_type(16)));
constexpr int GS_W = 0, GS_QD = GS_W + 64 * SPK * 2, GS_KT = GS_QD + 64 * SPK * 2, GS_AT = GS_KT + 128 * SPT * 2, GS_BUF = GS_AT + 64 * SPT * 2;
constexpr int GS_OBUF = 64 * SPT * 2;
static_assert(2 * GS_BUF + 2 * GS_OBUF <= LDS_CTL_OFF, "gdn_scan LDS map");
__device__ __forceinline__ bf16x8 pack8(const f32x16& x, int s) {
    const u32x4 v = (u32x4){pkc(x[8 * s], x[8 * s + 1]), pkc(x[8 * s + 2], x[8 * s + 3]), pkc(x[8 * s + 4], x[8 * s + 5]), pkc(x[8 * s + 6], x[8 * s + 7])};
    return __builtin_bit_cast(bf16x8, v); }
__device__ __forceinline__ void gdn_scan(const Ctx& C, int hh, int unit) {
    const int head = unit >> 1, dvh = unit & 1;
    const bf16_t* QKV = (const bf16_t*)(C.ws + WS_QKV); const bf16_t* GW = (const bf16_t*)(C.ws + WS_GW); const bf16_t* GATT = (const bf16_t*)(C.ws + WS_GATT);
    const float* GCD = (const float*)(C.ws + WS_GCD); bf16_t* GO = (bf16_t*)(C.out + (size_t)TH * 2048);
    const int lane = C.lane, w = C.wave;
    constexpr int NC = TH / 64;
    if (w >= 4) {
        const int lt = C.tid - 256; u32x4 pw[4], pq[4], pk[4], pa[2];
#define GS_LOAD(c_) do { const size_t item_ = (size_t)(c_) * 16 + head; const int t0_ = (c_) * 64; \
        _Pragma("unroll") for (int k = 0; k < 4; ++k) { const int q = lt + 256 * k, i = q >> 4, pc = q & 15; \
            pw[k] = *(const u32x4*)(GW + item_ * 8192 + i * 128 + pc * 8); \
            pq[k] = *(const u32x4*)(QKV + (size_t)(t0_ + i) * 8192 + head * 128 + pc * 8); \
            pk[k] = *(const u32x4*)(QKV + (size_t)(t0_ + i) * 8192 + 2048 + head * 128 + pc * 8); } \
        _Pragma("unroll") for (int k = 0; k < 2; ++k) { const int q = lt + 256 * k; pa[k] = *(const u32x4*)(GATT + item_ * 4096 + q * 8); } } while (0)
#define GS_STORE(b_) do { LAS unsigned char* B_ = C.lds + (b_) * GS_BUF; \
        _Pragma("unroll") for (int k = 0; k < 4; ++k) { const int q = lt + 256 * k, i = q >> 4, pc = q & 15; \
            *(LAS u32x4*)((LAS bf16_t*)(B_ + GS_W) + i * SPK + pc * 8) = pw[k]; *(LAS u32x4*)((LAS bf16_t*)(B_ + GS_QD) + i * SPK + pc * 8) = pq[k]; \
            *(LAS u32x4*)((LAS bf16_t*)(B_ + GS_KT) + (2 * i + (pc >> 3)) * SPT + (pc & 7) * 8) = pk[k]; } \
        _Pragma("unroll") for (int k = 0; k < 2; ++k) { const int q = lt + 256 * k; *(LAS u32x4*)((LAS bf16_t*)(B_ + GS_AT) + (q >> 3) * SPT + (q & 7) * 8) = pa[k]; } } while (0)
        GS_LOAD(0); GS_STORE(0); GS_LOAD(1);
        __syncthreads();
        for (int c = 0; c < NC; ++c) {
            if (c + 1 < NC) GS_STORE((c + 1) & 1);
            if (c + 2 < NC) GS_LOAD(c + 2);
            __syncthreads();
        }
#undef GS_LOAD
#undef GS_STORE
    } else {
        const int r = lane & 31, h2 = lane >> 5, dv = dvh * 128 + w * 32 + r;
        float* stp = (float*)(C.ws + WS_ST_GDN) + (size_t)(head * 256 + dv) * 128;
        f32x16 Sacc[4];
#pragma unroll
        for (int td = 0; td < 4; ++td)
#pragma unroll
            for (int q = 0; q < 4; ++q) { const f32x4 v = *(const f32x4*)(stp + 32 * td + 8 * q + 4 * h2);
                Sacc[td][4 * q] = v.x; Sacc[td][4 * q + 1] = v.y; Sacc[td][4 * q + 2] = v.z; Sacc[td][4 * q + 3] = v.w; }
        u32x2 urA[2][4], urB[2][4]; float cdA, cdB;
#define GS_ULOAD(c_, UR, CD) do { const int t0_ = (c_) * 64; \
        _Pragma("unroll") for (int ti = 0; ti < 2; ++ti) _Pragma("unroll") for (int q = 0; q < 4; ++q) \
            UR[ti][q] = *(const u32x2*)(QKV + (size_t)(t0_ + (dv >> 2)) * 8192 + 4096 + head * 256 + (dv & 3) * 64 + 32 * ti + 8 * q + 4 * h2); \
        CD = GCD[(size_t)(c_) * 16 + head]; } while (0)
        GS_ULOAD(0, urA, cdA);
        __syncthreads();
#define GS_FRAG(P_, off_) cat44(*(const LAS u32x2*)((P_) + (off_)), *(const LAS u32x2*)((P_) + (off_) + 8))
#define GS_LW(dst, P_, ti_, tp_) do { _Pragma("unroll") for (int t2 = 0; t2 < 2; ++t2) _Pragma("unroll") for (int s = 0; s < 2; ++s) dst[t2 * 2 + s] = GS_FRAG(P_, (32 * (ti_) + r) * SPK + 32 * (2 * (tp_) + t2) + 16 * s + 4 * h2); __builtin_amdgcn_sched_barrier(0); } while (0)
#define GS_MW(acc_, fr_, tp_) do { _Pragma("unroll") for (int t2 = 0; t2 < 2; ++t2) _Pragma("unroll") for (int s = 0; s < 2; ++s) acc_ = MFMA32(fr_[t2 * 2 + s], SB[2 * (tp_) + t2][s], acc_); } while (0)
#define GS_MWO(acc_, fr_, tp_) do { _Pragma("unroll") for (int t2 = 0; t2 < 2; ++t2) _Pragma("unroll") for (int s = 0; s < 2; ++s) acc_ = MFMA32(SB[2 * (tp_) + t2][s], fr_[t2 * 2 + s], acc_); } while (0)
#define GS_LA(dst, ti_) do { _Pragma("unroll") for (int tj = 0; tj < 2; ++tj) _Pragma("unroll") for (int s = 0; s < 2; ++s) dst[tj * 2 + s] = GS_FRAG(AT, (32 * (ti_) + r) * SPT + 32 * tj + 16 * s + 4 * h2); __builtin_amdgcn_sched_barrier(0); } while (0)
#define GS_LK(dst, td_) do { _Pragma("unroll") for (int ti = 0; ti < 2; ++ti) _Pragma("unroll") for (int s = 0; s < 2; ++s) dst[ti * 2 + s] = GS_FRAG(KT, (32 * (td_) + r) * SPT + 32 * ti + 16 * s + 4 * h2); __builtin_amdgcn_sched_barrier(0); } while (0)
#define GS_MV(acc_, fr_) do { _Pragma("unroll") for (int tj = 0; tj < 2; ++tj) _Pragma("unroll") for (int s = 0; s < 2; ++s) acc_ = MFMA32(fr_[tj * 2 + s], VBf[tj][s], acc_); } while (0)
#define GS_MVO(acc_, fr_) do { _Pragma("unroll") for (int tj = 0; tj < 2; ++tj) _Pragma("unroll") for (int s = 0; s < 2; ++s) acc_ = MFMA32(VBf[tj][s], fr_[tj * 2 + s], acc_); } while (0)
#define GS_BODY(c, UR, CD, URN, CDN) do { \
            const LAS unsigned char* B_ = C.lds + ((c) & 1) * GS_BUF; \
            const LAS bf16_t* Wl = (const LAS bf16_t*)(B_ + GS_W); const LAS bf16_t* QD = (const LAS bf16_t*)(B_ + GS_QD); \
            const LAS bf16_t* KT = (const LAS bf16_t*)(B_ + GS_KT); const LAS bf16_t* AT = (const LAS bf16_t*)(B_ + GS_AT); \
            const int t0 = (c) * 64; \
            bf16x8 SB[4][2]; \
            _Pragma("unroll") for (int td = 0; td < 4; ++td) { SB[td][0] = pack8(Sacc[td], 0); SB[td][1] = pack8(Sacc[td], 1); } \
            f32x16 T1[2], oacc[2]; bf16x8 f0[4], f1[4]; \
            _Pragma("unroll") for (int ti = 0; ti < 2; ++ti) _Pragma("unroll") for (int e = 0; e < 16; ++e) T1[ti][e] = 0.f; \
            GS_LW(f0, Wl, 0, 0); GS_LW(f1, Wl, 0, 1); \
            GS_MW(T1[0], f0, 0); GS_LW(f0, Wl, 1, 0); \
            GS_MW(T1[0], f1, 1); GS_LW(f1, Wl, 1, 1); \
            GS_MW(T1[1], f0, 0); GS_LW(f0, QD, 0, 0); \
            GS_MW(T1[1], f1, 1); GS_LW(f1, QD, 0, 1); \
            _Pragma("unroll") for (int ti = 0; ti < 2; ++ti) _Pragma("unroll") for (int e = 0; e < 16; ++e) oacc[ti][e] = 0.f; \
            GS_MWO(oacc[0], f0, 0); GS_LW(f0, QD, 1, 0); \
            bf16x8 VBf[2][2]; \
            _Pragma("unroll") for (int ti = 0; ti < 2; ++ti) { \
                _Pragma("unroll") for (int q = 0; q < 4; ++q) { T1[ti][4 * q] = bflo(UR[ti][q].x) - T1[ti][4 * q]; T1[ti][4 * q + 1] = bfhi(UR[ti][q].x) - T1[ti][4 * q + 1]; \
                    T1[ti][4 * q + 2] = bflo(UR[ti][q].y) - T1[ti][4 * q + 2]; T1[ti][4 * q + 3] = bfhi(UR[ti][q].y) - T1[ti][4 * q + 3]; } \
                VBf[ti][0] = pack8(T1[ti], 0); VBf[ti][1] = pack8(T1[ti], 1); } \
            const float cd = CD; \
            if ((c) + 1 < NC) GS_ULOAD((c) + 1, URN, CDN); \
            GS_MWO(oacc[0], f1, 1); GS_LW(f1, QD, 1, 1); \
            GS_MWO(oacc[1], f0, 0); GS_LA(f0, 0); \
            GS_MWO(oacc[1], f1, 1); GS_LA(f1, 1); \
            GS_MVO(oacc[0], f0); GS_LK(f0, 0); \
            GS_MVO(oacc[1], f1); GS_LK(f1, 1); \
            _Pragma("unroll") for (int td = 0; td < 4; ++td) Sacc[td] = Sacc[td] * cd; \
            GS_MV(Sacc[0], f0); GS_LK(f0, 2); \
            GS_MV(Sacc[1], f1); GS_LK(f1, 3); \
            GS_MV(Sacc[2], f0); GS_MV(Sacc[3], f1); \
            _Pragma("unroll") for (int ti = 0; ti < 2; ++ti) _Pragma("unroll") for (int q = 0; q < 4; ++q) \
                    *(u32x2*)(GO + (size_t)(t0 + 32 * ti + r) * 4096 + head * 256 + dvh * 128 + w * 32 + 8 * q + 4 * h2) = (u32x2){pkc(oacc[ti][4 * q], oacc[ti][4 * q + 1]), pkc(oacc[ti][4 * q + 2], oacc[ti][4 * q + 3])}; \
            __syncthreads(); \
        } while (0)
        for (int c2 = 0; c2 < NC; c2 += 2) { GS_BODY(c2, urA, cdA, urB, cdB); GS_BODY(c2 + 1, urB, cdB, urA, cdA); }
#undef GS_BODY
#undef GS_FRAG
#undef GS_LW
#undef GS_MW
#undef GS_LA
#undef GS_LK
#undef GS_MV
#undef GS_ULOAD
        { int l2 = lane; asm volatile("" : "+v"(l2)); const int dv2 = dvh * 128 + w * 32 + (l2 & 31), hh2 = l2 >> 5;
          float* sp2 = (float*)(C.ws + WS_ST_GDN) + (size_t)(head * 256 + dv2) * 128 + 4 * hh2;
#pragma unroll
          for (int td = 0; td < 4; ++td)
#pragma unroll
            for (int q = 0; q < 4; ++q) *(f32x4*)(sp2 + 32 * td + 8 * q) = (f32x4){Sacc[td][4 * q], Sacc[td][4 * q + 1], Sacc[td][4 * q + 2], Sacc[td][4 * q + 3]}; }
    }
}


__device__ __forceinline__ bf16x8 pack44(const f32x4& a, const f32x4& b) { const u32x4 v = (u32x4){pkc(a[0], a[1]), pkc(a[2], a[3]), pkc(b[0], b[1]), pkc(b[2], b[3])}; return __builtin_bit_cast(bf16x8, v); }
__device__ __forceinline__ void gdn_scan16(const Ctx& C, int hh, int unit) {
    const int head = unit >> 2, dvq = unit & 3;
    const bf16_t* QKV = (const bf16_t*)(C.ws + WS_QKV); const bf16_t* GW = (const bf16_t*)(C.ws + WS_GW); const bf16_t* GATT = (const bf16_t*)(C.ws + WS_GATT);
    const float* GCD = (const float*)(C.ws + WS_GCD); bf16_t* GO = (bf16_t*)(C.out + (size_t)TH * 2048);
    const int lane = C.lane, w = C.wave;
    constexpr int NC = TH / 64;
    if (w >= 4) {
        const int lt = C.tid - 256; u32x4 pwA[4], pqA[4], pkA[4], paA[2], pwB[4], pqB[4], pkB[4], paB[2];
#define GS_LOAD(c_, pw, pq, pk, pa) do { const size_t item_ = (size_t)(c_) * 16 + head; const int t0_ = (c_) * 64; \
        _Pragma("unroll") for (int k = 0; k < 4; ++k) { const int q = lt + 256 * k, i = q >> 4, pc = q & 15; \
            pw[k] = *(const u32x4*)(GW + item_ * 8192 + i * 128 + pc * 8); \
            pq[k] = *(const u32x4*)(QKV + (size_t)(t0_ + i) * 8192 + head * 128 + pc * 8); \
            pk[k] = *(const u32x4*)(QKV + (size_t)(t0_ + i) * 8192 + 2048 + head * 128 + pc * 8); } \
        _Pragma("unroll") for (int k = 0; k < 2; ++k) { const int q = lt + 256 * k; pa[k] = *(const u32x4*)(GATT + item_ * 4096 + q * 8); } } while (0)
#define GS_STORE(b_, pw, pq, pk, pa) do { LAS unsigned char* B_ = C.lds + (b_) * GS_BUF; \
        _Pragma("unroll") for (int k = 0; k < 4; ++k) { const int q = lt + 256 * k, i = q >> 4, pc = q & 15; \
            *(LAS u32x4*)((LAS bf16_t*)(B_ + GS_W) + i * SPK + pc * 8) = pw[k]; *(LAS u32x4*)((LAS bf16_t*)(B_ + GS_QD) + i * SPK + pc * 8) = pq[k]; \
            *(LAS u32x4*)((LAS bf16_t*)(B_ + GS_KT) + (2 * i + (pc >> 3)) * SPT + (pc & 7) * 8) = pk[k]; } \
        _Pragma("unroll") for (int k = 0; k < 2; ++k) { const int q = lt + 256 * k; *(LAS u32x4*)((LAS bf16_t*)(B_ + GS_AT) + (q >> 3) * SPT + (q & 7) * 8) = pa[k]; } } while (0)
#define GS_OCOPY(c_) do { const LAS bf16_t* OS_ = (const LAS bf16_t*)(C.lds + 2 * GS_BUF + ((c_) & 1) * GS_OBUF); \
        _Pragma("unroll") for (int k = 0; k < 2; ++k) { const int q = lt + 256 * k, row = q >> 3, pc = q & 7; \
            *(u32x4*)(GO + (size_t)((c_) * 64 + row) * 4096 + head * 256 + dvq * 64 + pc * 8) = *(const LAS u32x4*)(OS_ + row * SPT + pc * 8); } } while (0)
        GS_LOAD(0, pwA, pqA, pkA, paA); GS_STORE(0, pwA, pqA, pkA, paA); GS_LOAD(1, pwB, pqB, pkB, paB); GS_LOAD(2, pwA, pqA, pkA, paA);
        __syncthreads();
        for (int c = 0; c < NC; c += 2) {
            if (c + 1 < NC) GS_STORE(1, pwB, pqB, pkB, paB);
            if (c + 3 < NC) GS_LOAD(c + 3, pwB, pqB, pkB, paB);
            if (c > 0) GS_OCOPY(c - 1);
            __syncthreads();
            if (c + 2 < NC) GS_STORE(0, pwA, pqA, pkA, paA);
            if (c + 4 < NC) GS_LOAD(c + 4, pwA, pqA, pkA, paA);
            GS_OCOPY(c);
            __syncthreads();
        }
        GS_OCOPY(NC - 1);
#undef GS_LOAD
#undef GS_STORE
#undef GS_OCOPY
    } else {
        const int i16 = lane & 15, g = lane >> 4, dv = dvq * 64 + w * 16 + i16;
        float* stp = (float*)(C.ws + WS_ST_GDN) + (size_t)(head * 256 + dv) * 128 + 4 * g;
        f32x4 Sacc[8];
#pragma unroll
        for (int td = 0; td < 8; ++td) Sacc[td] = *(const f32x4*)(stp + 16 * td);
        u32x2 urA[4], urB[4]; float cdA, cdB;
#define G16_ULOAD(c_, UR, CD) do { const int t0_ = (c_) * 64; \
        _Pragma("unroll") for (int ti = 0; ti < 4; ++ti) UR[ti] = *(const u32x2*)(QKV + (size_t)(t0_ + (dv >> 2)) * 8192 + 4096 + head * 256 + (dv & 3) * 64 + 16 * ti + 4 * g); \
        CD = GCD[(size_t)(c_) * 16 + head]; } while (0)
        G16_ULOAD(0, urA, cdA); G16_ULOAD(1, urB, cdB);
        __syncthreads();
#define G16_FR(P_, row_, pitch_, j_) (*(const LAS bf16x8*)((P_) + (row_) * (pitch_) + 32 * (j_) + 8 * g))
#define G16_BODY(c, UR, CD) do { \
            const LAS unsigned char* B_ = C.lds + ((c) & 1) * GS_BUF; \
            const LAS bf16_t* Wl = (const LAS bf16_t*)(B_ + GS_W); const LAS bf16_t* QD = (const LAS bf16_t*)(B_ + GS_QD); \
            const LAS bf16_t* KT = (const LAS bf16_t*)(B_ + GS_KT); const LAS bf16_t* AT = (const LAS bf16_t*)(B_ + GS_AT); \
            const int t0 = (c) * 64; \
            bf16x8 SB[4]; \
            _Pragma("unroll") for (int j = 0; j < 4; ++j) SB[j] = pack44(Sacc[2 * j], Sacc[2 * j + 1]); \
            const float cd = CD; \
            _Pragma("unroll") for (int td = 0; td < 8; ++td) Sacc[td] = Sacc[td] * cd;     \
            f32x4 T1[4], oacc[4]; bf16x8 fw[16], fq[16]; \
            _Pragma("unroll") for (int ti = 0; ti < 4; ++ti) { T1[ti] = (f32x4){0.f, 0.f, 0.f, 0.f}; oacc[ti] = (f32x4){0.f, 0.f, 0.f, 0.f}; } \
            _Pragma("unroll") for (int ti = 0; ti < 4; ++ti) _Pragma("unroll") for (int j = 0; j < 4; ++j) fw[ti * 4 + j] = G16_FR(Wl, 16 * ti + i16, SPK, j); \
            __builtin_amdgcn_sched_barrier(0); \
            _Pragma("unroll") for (int ti = 0; ti < 4; ++ti) _Pragma("unroll") for (int j = 0; j < 4; ++j) fq[ti * 4 + j] = G16_FR(QD, 16 * ti + i16, SPK, j); \
            _Pragma("unroll") for (int ti = 0; ti < 4; ++ti) _Pragma("unroll") for (int j = 0; j < 4; ++j) T1[ti] = MFMA16(fw[ti * 4 + j], SB[j], T1[ti]); \
            __builtin_amdgcn_sched_barrier(0); \
            _Pragma("unroll") for (int ti = 0; ti < 4; ++ti) _Pragma("unroll") for (int jj = 0; jj < 2; ++jj) fw[ti * 2 + jj] = G16_FR(AT, 16 * ti + i16, SPT, jj); \
            _Pragma("unroll") for (int ti = 0; ti < 4; ++ti) _Pragma("unroll") for (int j = 0; j < 4; ++j) oacc[ti] = MFMA16(SB[j], fq[ti * 4 + j], oacc[ti]); \
            __builtin_amdgcn_sched_barrier(0); \
            f32x4 vn[4]; \
            _Pragma("unroll") for (int ti = 0; ti < 4; ++ti) { vn[ti][0] = bflo(UR[ti].x) - T1[ti][0]; vn[ti][1] = bfhi(UR[ti].x) - T1[ti][1]; vn[ti][2] = bflo(UR[ti].y) - T1[ti][2]; vn[ti][3] = bfhi(UR[ti].y) - T1[ti][3]; } \
            const bf16x8 VB0 = pack44(vn[0], vn[1]), VB1 = pack44(vn[2], vn[3]); \
            if ((c) + 2 < NC) G16_ULOAD((c) + 2, UR, CD); \
            _Pragma("unroll") for (int td = 0; td < 8; ++td) { fq[td * 2] = G16_FR(KT, 16 * td + i16, SPT, 0); fq[td * 2 + 1] = G16_FR(KT, 16 * td + i16, SPT, 1); } \
            _Pragma("unroll") for (int ti = 0; ti < 4; ++ti) { oacc[ti] = MFMA16(VB0, fw[ti * 2], oacc[ti]); oacc[ti] = MFMA16(VB1, fw[ti * 2 + 1], oacc[ti]); } \
            __builtin_amdgcn_sched_barrier(0); \
            _Pragma("unroll") for (int td = 0; td < 8; ++td) { Sacc[td] = MFMA16(fq[td * 2], VB0, Sacc[td]); Sacc[td] = MFMA16(fq[td * 2 + 1], VB1, Sacc[td]); } \
            { LAS bf16_t* OS_ = (LAS bf16_t*)(C.lds + 2 * GS_BUF + ((c) & 1) * GS_OBUF); \
              _Pragma("unroll") for (int ti = 0; ti < 4; ++ti) *(LAS u32x2*)(OS_ + (16 * ti + i16) * SPT + w * 16 + 4 * g) = (u32x2){pkc(oacc[ti][0], oacc[ti][1]), pkc(oacc[ti][2], oacc[ti][3])}; } \
            __syncthreads(); \
        } while (0)
        for (int c2 = 0; c2 < NC; c2 += 2) { G16_BODY(c2, urA, cdA); G16_BODY(c2 + 1, urB, cdB); }
#undef G16_BODY
#undef G16_FR
#undef G16_ULOAD
        { int l2 = lane; asm volatile("" : "+v"(l2)); const int dv2 = dvq * 64 + w * 16 + (l2 & 15);
          float* sp2 = (float*)(C.ws + WS_ST_GDN) + (size_t)(head * 256 + dv2) * 128 + 4 * (l2 >> 4);
#pragma unroll
          for (int td = 0; td < 8; ++td) *(f32x4*)(sp2 + 16 * td) = Sacc[td]; }
    }
}

__device__ __forceinline__ void p4_post(const Ctx& C) {
    const int lane = C.lane, w = C.wave;
    const bf16_t* XBC = (const bf16_t*)(C.ws + WS_XBC); bf16_t* ZS = (bf16_t*)(C.ws + WS_ZSSM);
    const bf16_t* GOB = (const bf16_t*)(C.out + (size_t)TH * 2048); bf16_t* ZG = (bf16_t*)(C.ws + WS_ZGDN);
    const int cs = w * 512 + lane * 8, cgd = w * 512 + lane * 8, cw = (lane & 31) * 8;
    const f32x4 sw0 = *(const f32x4*)(C.in(I_SNW) + cs), sw1 = *(const f32x4*)(C.in(I_SNW) + cs + 4);
    const f32x4 gw0 = *(const f32x4*)(C.in(I_GNW) + cw), gw1 = *(const f32x4*)(C.in(I_GNW) + cw + 4);
    for (int tb = C.bid * 4; tb < TH; tb += C.G * 4) {
        u32x4 yv[4], zv[4], ov[4], gv[4];
#pragma unroll
        for (int b = 0; b < 4; ++b) { const size_t t = tb + b;
            yv[b] = *(const u32x4*)(XBC + t * 6144 + cs); zv[b] = *(const u32x4*)(ZS + t * 4096 + cs);
            ov[b] = *(const u32x4*)(GOB + t * 4096 + cgd); gv[b] = *(const u32x4*)(ZG + t * 4096 + cgd); }
#pragma unroll
        for (int b = 0; b < 4; ++b) { const size_t t = tb + b;
            { float y[8]; unpack8(yv[b], y); float z[8]; unpack8(zv[b], z); float ss = 0.f;
#pragma unroll
              for (int e = 0; e < 8; ++e) { y[e] *= siluf_(z[e]); ss += y[e] * y[e]; }
              const float sc = rsqrtf(wave_sum(ss) * (1.0f / 512.0f) + EPS);
              u32x4 o; o.x = pk2(y[0] * sc * sw0.x, y[1] * sc * sw0.y); o.y = pk2(y[2] * sc * sw0.z, y[3] * sc * sw0.w); o.z = pk2(y[4] * sc * sw1.x, y[5] * sc * sw1.y); o.w = pk2(y[6] * sc * sw1.z, y[7] * sc * sw1.w);
              *(u32x4*)(ZS + t * 4096 + cs) = o; }
            { float o[8]; unpack8(ov[b], o); float z[8]; unpack8(gv[b], z); float ss = 0.f;
#pragma unroll
              for (int e = 0; e < 8; ++e) ss += o[e] * o[e];
#pragma unroll
              for (int m = 1; m < 32; m <<= 1) ss += __shfl_xor(ss, m);
              const float sc = rsqrtf(ss * (1.0f / 256.0f) + EPS);
              u32x4 r; r.x = pk2(o[0] * sc * gw0.x * siluf_(z[0]), o[1] * sc * gw0.y * siluf_(z[1])); r.y = pk2(o[2] * sc * gw0.z * siluf_(z[2]), o[3] * sc * gw0.w * siluf_(z[3]));
              r.z = pk2(o[4] * sc * gw1.x * siluf_(z[4]), o[5] * sc * gw1.y * siluf_(z[5])); r.w = pk2(o[6] * sc * gw1.z * siluf_(z[6]), o[7] * sc * gw1.w * siluf_(z[7]));
              *(u32x4*)(ZG + t * 4096 + cgd) = r; } }
    }
}

template <int N> __device__ __forceinline__ void bitonic_sort_desc(unsigned (&a)[N]) {
#pragma unroll
    for (int k = 2; k <= N; k <<= 1)
#pragma unroll
        for (int j = k >> 1; j > 0; j >>= 1)
#pragma unroll
            for (int i = 0; i < N; ++i) { const int l = i ^ j; if (l > i) { const bool desc = ((i & k) == 0);
                const unsigned hi = a[i] > a[l] ? a[i] : a[l], lo = a[i] > a[l] ? a[l] : a[i]; a[i] = desc ? hi : lo; a[l] = desc ? lo : hi; } }
}
template <int N> __device__ __forceinline__ void bitonic_merge_desc(unsigned (&a)[N]) {
#pragma unroll
    for (int j = N >> 1; j > 0; j >>= 1)
#pragma unroll
        for (int i = 0; i < N; ++i) { const int l = i ^ j; if (l > i) { const unsigned hi = a[i] > a[l] ? a[i] : a[l], lo = a[i] > a[l] ? a[l] : a[i]; a[i] = hi; a[l] = lo; } }
}
template <int M> __device__ __forceinline__ void merge_lanes16(unsigned (&a)[16]) {
    unsigned o[16];
#pragma unroll
    for (int i = 0; i < 16; ++i) o[i] = (unsigned)__shfl_xor((int)a[i], M);
#pragma unroll
    for (int i = 0; i < 16; ++i) a[i] = a[i] > o[15 - i] ? a[i] : o[15 - i];
    bitonic_merge_desc<16>(a);
}
__device__ __forceinline__ unsigned f2key(float f) { const unsigned u = __float_as_uint(f); return u ^ ((unsigned)((int)u >> 31) | 0x80000000u); }
__device__ __forceinline__ float key2f(unsigned k) { return __uint_as_float((k & 0x80000000u) ? (k & 0x7fffffffu) : ~k); }
__device__ __forceinline__ void p9_scores(const Ctx& C) {
    const bf16_t* Q = (const bf16_t*)(C.ws + WS_Q); const bf16_t* SKB = (const bf16_t*)(C.ws + WS_SKB);
    int* PIDX = (int*)(C.ws + WS_PIDX); float* PGATE = (float*)(C.ws + WS_PGATE);
    const int lane = C.lane, h = C.wave, fr = lane & 15, fq = lane >> 4;
    LAS int* tab = (LAS int*)C.lds + h * 512;
    const float* SSQ = (const float*)(C.ws + WS_SSQ); float* RSTD = (float*)(C.ws + WS_RSTD);
    for (int tile = C.bid; tile < T / 16; tile += C.G) {
        const int tok0 = tile * 16;
        float rstd;
        { const f32x4 s0 = *(const f32x4*)(SSQ + (size_t)(tok0 + fr) * 32 + fq * 8), s1 = *(const f32x4*)(SSQ + (size_t)(tok0 + fr) * 32 + fq * 8 + 4);
          float ss = ((s0.x + s0.y) + (s0.z + s0.w)) + ((s1.x + s1.y) + (s1.z + s1.w)); ss += __shfl_xor(ss, 16); ss += __shfl_xor(ss, 32);
          rstd = rsqrtf(ss * (1.0f / 2048.0f) + EPS); if (h == 0 && fq == 0) RSTD[tok0 + fr] = rstd; }
        unsigned K[2][16];
#pragma unroll
        for (int p = 0; p < 2; ++p) {
            bf16x8 a[4];
#pragma unroll
            for (int ks = 0; ks < 4; ++ks) a[ks] = *(const bf16x8*)(Q + (size_t)(tok0 + fr) * 2048 + h * 256 + p * 128 + ks * 32 + fq * 8);
            unsigned ka[16], kb[16];
#pragma unroll
            for (int n4 = 0; n4 < 2; ++n4) { bf16x8 b[16];
#pragma unroll
                for (int q = 0; q < 16; ++q) b[q] = *(const bf16x8*)(SKB + (size_t)((h * 2 + p) * 128 + (n4 * 4 + (q >> 2)) * 16 + fr) * 128 + (q & 3) * 32 + fq * 8);
                __builtin_amdgcn_sched_barrier(0);
#pragma unroll
                for (int n2 = 0; n2 < 4; ++n2) { const int nt = n4 * 4 + n2; f32x4 acc = (f32x4){0.f, 0.f, 0.f, 0.f};
#pragma unroll
                    for (int ks = 0; ks < 4; ++ks) acc = __builtin_amdgcn_mfma_f32_16x16x32_bf16(b[n2 * 4 + ks], a[ks], acc, 0, 0, 0);
#pragma unroll
                    for (int i = 0; i < 4; ++i) { const unsigned key = (f2key(acc[i]) & ~127u) | (unsigned)(127 - (nt * 16 + 4 * fq + i));
                        if (n4 == 0) ka[n2 * 4 + i] = key; else kb[n2 * 4 + i] = key; } } }
            bitonic_sort_desc<16>(ka); bitonic_sort_desc<16>(kb);
#pragma unroll
            for (int i = 0; i < 16; ++i) ka[i] = ka[i] > kb[15 - i] ? ka[i] : kb[15 - i];
            bitonic_merge_desc<16>(ka);
            merge_lanes16<16>(ka); merge_lanes16<32>(ka);
#pragma unroll
            for (int i = 0; i < 16; ++i) K[p][i] = ka[i];
        }
        if (fq == 0) {
#pragma unroll
            for (int i = 0; i < 16; ++i) { tab[fr * 32 + i] = 127 - (int)(K[0][i] & 127u); tab[fr * 32 + 16 + i] = 127 - (int)(K[1][i] & 127u); } }
        unsigned cd[16];
        { unsigned ck[52]; int nc = 0;
#pragma unroll
          for (int i = 0; i < 16; ++i)
#pragma unroll
              for (int j = 0; j < 16; ++j) if ((i + 1) * (j + 1) <= 16) { ck[nc] = (f2key(key2f(K[0][i] & ~127u) + key2f(K[1][j] & ~127u)) & ~255u) | (unsigned)(255 - (i * 16 + j)); ++nc; }
          ck[50] = 0u; ck[51] = 0u;
#pragma unroll
          for (int m = 0; m < 13; ++m) cd[m] = fq == 0 ? ck[4 * m] : (fq == 1 ? ck[4 * m + 1] : (fq == 2 ? ck[4 * m + 2] : ck[4 * m + 3]));
          cd[13] = 0u; cd[14] = 0u; cd[15] = 0u; }
        bitonic_sort_desc<16>(cd);
        merge_lanes16<16>(cd); merge_lanes16<32>(cd);
        LDS_WAIT(); asm volatile("" ::: "memory");
        float ex[16]; int id[16]; float sum = 0.f; const float mx = key2f(cd[0] & ~255u);
#pragma unroll
        for (int it = 0; it < 16; ++it) { ex[it] = __expf((key2f(cd[it] & ~255u) - mx) * rstd);     sum += ex[it]; const int flat = 255 - (int)(cd[it] & 255u);
            id[it] = tab[fr * 32 + (flat >> 4)] * 128 + tab[fr * 32 + 16 + (flat & 15)]; }
        const float inv = 1.0f / sum;
        int4 oi; f32x4 og;
        oi.x = fq == 0 ? id[0] : (fq == 1 ? id[4] : (fq == 2 ? id[8] : id[12])); oi.y = fq == 0 ? id[1] : (fq == 1 ? id[5] : (fq == 2 ? id[9] : id[13]));
        oi.z = fq == 0 ? id[2] : (fq == 1 ? id[6] : (fq == 2 ? id[10] : id[14])); oi.w = fq == 0 ? id[3] : (fq == 1 ? id[7] : (fq == 2 ? id[11] : id[15]));
        og.x = (fq == 0 ? ex[0] : (fq == 1 ? ex[4] : (fq == 2 ? ex[8] : ex[12]))) * inv; og.y = (fq == 0 ? ex[1] : (fq == 1 ? ex[5] : (fq == 2 ? ex[9] : ex[13]))) * inv;
        og.z = (fq == 0 ? ex[2] : (fq == 1 ? ex[6] : (fq == 2 ? ex[10] : ex[14]))) * inv; og.w = (fq == 0 ? ex[3] : (fq == 1 ? ex[7] : (fq == 2 ? ex[11] : ex[15]))) * inv;
        *(int4*)(PIDX + (size_t)(tok0 + fr) * 128 + h * 16 + 4 * fq) = oi;
        *(f32x4*)(PGATE + (size_t)(tok0 + fr) * 128 + h * 16 + 4 * fq) = og;
        LDS_WAIT(); asm volatile("" ::: "memory");
    }
}

__device__ __forceinline__ void p10_peer_naive(const Ctx& C) {
    const int gw = C.bid * NWAVES + C.wave, NGW = C.G * NWAVES, lane = C.lane;
    const bf16_t* HN = (const bf16_t*)(C.ws + WS_XN); const int* PIDX = (const int*)(C.ws + WS_PIDX); const float* PGATE = (const float*)(C.ws + WS_PGATE);
    const float* U = C.in(I_PU); const float* V = C.in(I_PV);
    for (int t = gw; t < T; t += NGW) {
        f32x4 hv[8], acc[8];
#pragma unroll
        for (int j = 0; j < 8; ++j) { const u32x2 w = *((const u32x2*)(HN + (size_t)t * 2048) + lane + 64 * j); hv[j] = (f32x4){bflo(w.x), bfhi(w.x), bflo(w.y), bfhi(w.y)}; acc[j] = (f32x4){0.f, 0.f, 0.f, 0.f}; }
        const int ia = PIDX[(size_t)t * 128 + lane], ib = PIDX[(size_t)t * 128 + 64 + lane];
        const float ga = PGATE[(size_t)t * 128 + lane], gb = PGATE[(size_t)t * 128 + 64 + lane];
#pragma unroll 2
        for (int e = 0; e < 128; ++e) {
            const int id = __shfl(e < 64 ? ia : ib, e & 63); const float gt = __shfl(e < 64 ? ga : gb, e & 63);
            const f32x4* ur = (const f32x4*)(U + (size_t)id * 2048) + lane; float d = 0.f;
#pragma unroll
            for (int j = 0; j < 8; ++j) { const f32x4 uu = ur[64 * j]; d += (uu.x * hv[j].x + uu.y * hv[j].y) + (uu.z * hv[j].z + uu.w * hv[j].w); }
            d = wave_sum(d);
            const float cf = gt * 0.5f * d * (1.0f + erff(d * 0.70710678118f));
            const f32x4* vr = (const f32x4*)(V + (size_t)id * 2048) + lane;
#pragma unroll
            for (int j = 0; j < 8; ++j) acc[j] += vr[64 * j] * cf;
        }
        f32x4* hr = (f32x4*)(C.out + (size_t)t * 2048) + lane; float ss = 0.f;
#pragma unroll
        for (int j = 0; j < 8; ++j) { acc[j] += hr[64 * j]; ss += (acc[j].x * acc[j].x + acc[j].y * acc[j].y) + (acc[j].z * acc[j].z + acc[j].w * acc[j].w); }
        const float r = rsqrtf(wave_sum(ss) * (1.0f / 2048.0f) + EPS);
        const f32x4* fw = (const f32x4*)C.in(I_FINW) + lane;
#pragma unroll
        for (int j = 0; j < 8; ++j) hr[64 * j] = acc[j] * r * fw[64 * j];
    }
}


constexpr float U8_SCALE = 64.0f, V8_SCALE = 8.0f;
__device__ __forceinline__ void tables_to_fp8(const Ctx& C, int first_wg) {
    const int gt = (C.bid - first_wg) * NTHREADS + C.tid, NGT = (C.G - first_wg) * NTHREADS;
    const f32x4* U = (const f32x4*)C.in(I_PU); const f32x4* V = (const f32x4*)C.in(I_PV); u32x4* U8 = (u32x4*)(C.ws + WS_U8); u32x4* V8 = (u32x4*)(C.ws + WS_V8);
    for (int it = gt; it < 2 * (16384 * 2048 / 16); it += NGT) { const int which = it >= (16384 * 2048 / 16), i = which ? it - (16384 * 2048 / 16) : it;
        const f32x4* src = (which ? V : U) + (size_t)i * 4; const float sc = which ? V8_SCALE : U8_SCALE; u32x4 o;
        const f32x4* fw = (const f32x4*)C.in(I_FNW) + (i & 127) * 4;
#pragma unroll
        for (int d = 0; d < 4; ++d) { f32x4 v = src[d]; if (!which) v = v * fw[d]; unsigned wv = 0u; wv = __builtin_amdgcn_cvt_pk_fp8_f32(v.x * sc, v.y * sc, wv, false); wv = __builtin_amdgcn_cvt_pk_fp8_f32(v.z * sc, v.w * sc, wv, true); o[d] = wv; }
        (which ? V8 : U8)[i] = o; }
}
__device__ __forceinline__ void peer_load4(const unsigned char* T8, int i0, int i1, int i2, int i3, int lane, u32x4 (&r)[4][2]) {
    const unsigned char* b0 = T8 + (size_t)i0 * 2048 + lane * 16; const unsigned char* b1 = T8 + (size_t)i1 * 2048 + lane * 16;
    const unsigned char* b2 = T8 + (size_t)i2 * 2048 + lane * 16; const unsigned char* b3 = T8 + (size_t)i3 * 2048 + lane * 16;
    r[0][0] = *(const u32x4*)b0; r[0][1] = *(const u32x4*)(b0 + 1024); r[1][0] = *(const u32x4*)b1; r[1][1] = *(const u32x4*)(b1 + 1024);
    r[2][0] = *(const u32x4*)b2; r[2][1] = *(const u32x4*)(b2 + 1024); r[3][0] = *(const u32x4*)b3; r[3][1] = *(const u32x4*)(b3 + 1024);
}
__device__ __forceinline__ void p10_peer(const Ctx& C) {
    const int gw = C.bid * NWAVES + C.wave, NGW = C.G * NWAVES, lane = C.lane;
    const bf16_t* HN = (const bf16_t*)(C.ws + WS_XN); const int* PIDX = (const int*)(C.ws + WS_PIDX); const float* PGATE = (const float*)(C.ws + WS_PGATE);
    const unsigned char* U8 = C.ws + WS_U8; const unsigned char* V8 = C.ws + WS_V8;
    for (int t = gw; t < T; t += NGW) {
        float hv[2][16], acc[2][16];
#pragma unroll
        for (int j = 0; j < 2; ++j) { const u32x4 a = *(const u32x4*)(HN + (size_t)t * 2048 + j * 1024 + lane * 16), b = *(const u32x4*)(HN + (size_t)t * 2048 + j * 1024 + lane * 16 + 8);
            float f[8]; unpack8(a, f);
#pragma unroll
            for (int e = 0; e < 8; ++e) hv[j][e] = f[e];
            unpack8(b, f);
#pragma unroll
            for (int e = 0; e < 8; ++e) { hv[j][8 + e] = f[e]; }
#pragma unroll
            for (int e = 0; e < 16; ++e) acc[j][e] = 0.f; }
        const int ia = PIDX[(size_t)t * 128 + lane], ib = PIDX[(size_t)t * 128 + 64 + lane];
        const float ga = PGATE[(size_t)t * 128 + lane], gb = PGATE[(size_t)t * 128 + 64 + lane];
        u32x4 uA[4][2], vv[4][2];
#define PEER_IDS(g_) const int sl_ = ((g_) * 4) & 63; const int src_ = (g_) < 16 ? ia : ib; \
        const int i0 = __builtin_amdgcn_readlane(src_, sl_), i1 = __builtin_amdgcn_readlane(src_, sl_ + 1), i2 = __builtin_amdgcn_readlane(src_, sl_ + 2), i3 = __builtin_amdgcn_readlane(src_, sl_ + 3)
#define PEER_COMPUTE(g_, UU) do { \
        { PEER_IDS(g_); peer_load4(V8, i0, i1, i2, i3, lane, vv); } \
        float p[4]; \
        _Pragma("unroll") for (int e = 0; e < 4; ++e) { float s0 = 0.f, s1 = 0.f; \
            _Pragma("unroll") for (int j = 0; j < 2; ++j) _Pragma("unroll") for (int d = 0; d < 4; ++d) { const unsigned wv = UU[e][j][d]; \
                const f32x2 lo = __builtin_amdgcn_cvt_pk_f32_fp8(wv, false), hi = __builtin_amdgcn_cvt_pk_f32_fp8(wv, true); \
                s0 += lo.x * hv[j][4 * d] + hi.x * hv[j][4 * d + 2]; s1 += lo.y * hv[j][4 * d + 1] + hi.y * hv[j][4 * d + 3]; } \
            p[e] = s0 + s1; } \
        if ((g_) + 1 < 32) { PEER_IDS((g_) + 1); peer_load4(U8, i0, i1, i2, i3, lane, UU); }     \
        const bool b0 = lane & 1, b1 = lane & 2; \
        float kA = b0 ? p[2] : p[0], kB = b0 ? p[3] : p[1]; const float sA = b0 ? p[0] : p[2], sB = b0 ? p[1] : p[3]; \
        kA += __shfl_xor(sA, 1); kB += __shfl_xor(sB, 1); \
        float kk = b1 ? kB : kA; const float ss = b1 ? kA : kB; kk += __shfl_xor(ss, 2); \
        kk += __shfl_xor(kk, 4); kk += __shfl_xor(kk, 8); kk += __shfl_xor(kk, 16); kk += __shfl_xor(kk, 32); \
        const int el = 2 * (lane & 1) + ((lane >> 1) & 1);                        \
        const float gt = __shfl((g_) < 16 ? ga : gb, (((g_) * 4) & 63) + el); \
        const float dd = kk * (1.0f / U8_SCALE); const float cfl = gt * 0.5f * dd * (1.0f + erff(dd * 0.70710678118f)) * (1.0f / V8_SCALE); \
        const int cfi = __float_as_int(cfl); float cf[4]; cf[0] = __int_as_float(__builtin_amdgcn_readlane(cfi, 0)); cf[1] = __int_as_float(__builtin_amdgcn_readlane(cfi, 2)); cf[2] = __int_as_float(__builtin_amdgcn_readlane(cfi, 1)); cf[3] = __int_as_float(__builtin_amdgcn_readlane(cfi, 3)); \
        _Pragma("unroll") for (int e = 0; e < 4; ++e) _Pragma("unroll") for (int j = 0; j < 2; ++j) _Pragma("unroll") for (int d = 0; d < 4; ++d) { const unsigned wv = vv[e][j][d]; \
            const f32x2 lo = __builtin_amdgcn_cvt_pk_f32_fp8(wv, false), hi = __builtin_amdgcn_cvt_pk_f32_fp8(wv, true); \
            acc[j][4 * d] += cf[e] * lo.x; acc[j][4 * d + 1] += cf[e] * lo.y; acc[j][4 * d + 2] += cf[e] * hi.x; acc[j][4 * d + 3] += cf[e] * hi.y; } } while (0)
        { PEER_IDS(0); peer_load4(U8, i0, i1, i2, i3, lane, uA); }
#pragma unroll 1
        for (int g = 0; g < 32; ++g) { PEER_COMPUTE(g, uA); }
#undef PEER_IDS
#undef PEER_COMPUTE
        float* hr = C.out + (size_t)t * 2048; float ss2 = 0.f;
#pragma unroll
        for (int j = 0; j < 2; ++j)
#pragma unroll
            for (int d = 0; d < 4; ++d) { const f32x4 hq = *(const f32x4*)(hr + j * 1024 + lane * 16 + 4 * d);
                acc[j][4 * d] += hq.x; acc[j][4 * d + 1] += hq.y; acc[j][4 * d + 2] += hq.z; acc[j][4 * d + 3] += hq.w;
                ss2 += (acc[j][4 * d] * acc[j][4 * d] + acc[j][4 * d + 1] * acc[j][4 * d + 1]) + (acc[j][4 * d + 2] * acc[j][4 * d + 2] + acc[j][4 * d + 3] * acc[j][4 * d + 3]); }
        const float rr = rsqrtf(wave_sum(ss2) * (1.0f / 2048.0f) + EPS);
        const float* fw = C.in(I_FINW);
#pragma unroll
        for (int j = 0; j < 2; ++j)
#pragma unroll
            for (int d = 0; d < 4; ++d) { const f32x4 wq = *(const f32x4*)(fw + j * 1024 + lane * 16 + 4 * d);
                *(f32x4*)(hr + j * 1024 + lane * 16 + 4 * d) = (f32x4){acc[j][4 * d] * rr * wq.x, acc[j][4 * d + 1] * rr * wq.y, acc[j][4 * d + 2] * rr * wq.z, acc[j][4 * d + 3] * rr * wq.w}; }
    }
}


template <int M0> __device__ __forceinline__ void reduce16to2(const float (&v)[16], int lane, float& o0, float& o1) {
    float w8[8], w4[4];
    { const bool b = lane & M0;
#pragma unroll
      for (int i = 0; i < 8; ++i) { const float keep = b ? v[8 + i] : v[i], send = b ? v[i] : v[8 + i]; w8[i] = keep + __shfl_xor(send, M0); } }
    { const bool b = lane & (2 * M0);
#pragma unroll
      for (int i = 0; i < 4; ++i) { const float keep = b ? w8[4 + i] : w8[i], send = b ? w8[i] : w8[4 + i]; w4[i] = keep + __shfl_xor(send, 2 * M0); } }
    { const bool b = lane & (4 * M0);
      const float k0 = b ? w4[2] : w4[0], s0 = b ? w4[0] : w4[2], k1 = b ? w4[3] : w4[1], s1 = b ? w4[1] : w4[3];
      o0 = k0 + __shfl_xor(s0, 4 * M0); o1 = k1 + __shfl_xor(s1, 4 * M0); }
}
__device__ __forceinline__ void p10_peer_sliced(const Ctx& C) {
    const int gw = C.bid * NWAVES + C.wave, NGW = C.G * NWAVES, lane = C.lane, eg = lane >> 3, c = lane & 7;
    const bf16_t* HN = (const bf16_t*)(C.ws + WS_XN); const int* PIDX = (const int*)(C.ws + WS_PIDX); const float* PGATE = (const float*)(C.ws + WS_PGATE);
    const unsigned char* U8 = C.ws + WS_U8; const unsigned char* V8 = C.ws + WS_V8; const float* RSTD = (const float*)(C.ws + WS_RSTD);
    LAS unsigned* offs = (LAS unsigned*)(C.lds + C.wave * 8192);
    LAS float* coefl = (LAS float*)(C.lds + C.wave * 8192 + 4096);
    const int jc = 8 * (c & 1) + 4 * ((c >> 1) & 1) + 2 * ((c >> 2) & 1);
    const int je = 8 * (eg & 1) + 4 * ((eg >> 1) & 1) + 2 * ((eg >> 2) & 1);
    const int e0 = 8 * jc + eg, e1 = 8 * (jc + 1) + eg;
    for (int tb = gw * 8; tb < T; tb += NGW * 8) {
#pragma unroll
        for (int k = 0; k < 8; ++k) { offs[k * 128 + lane] = (unsigned)PIDX[(size_t)(tb + k) * 128 + lane] << 11; offs[k * 128 + 64 + lane] = (unsigned)PIDX[(size_t)(tb + k) * 128 + 64 + lane] << 11;
            coefl[k * 128 + lane] = 0.f; coefl[k * 128 + 64 + lane] = 0.f; }
        LDS_WAIT(); asm volatile("" ::: "memory");
#pragma unroll 1
        for (int s = 0; s < 16; ++s) {
            const unsigned char* ub = U8 + s * 128 + c * 16;
#pragma unroll 1
            for (int k = 0; k < 8; ++k) {
                const LAS unsigned* ok = offs + k * 128 + eg;
                u32x4 r[16];
#pragma unroll
                for (int i = 0; i < 16; ++i) r[i] = *(const u32x4*)(ub + ok[8 * i]);
                f32x2 hf[8];
                { const u32x4 ha = *(const u32x4*)(HN + (size_t)(tb + k) * 2048 + s * 128 + c * 16), hb = *(const u32x4*)(HN + (size_t)(tb + k) * 2048 + s * 128 + c * 16 + 8);
                  hf[0] = (f32x2){bflo(ha.x), bfhi(ha.x)}; hf[1] = (f32x2){bflo(ha.y), bfhi(ha.y)}; hf[2] = (f32x2){bflo(ha.z), bfhi(ha.z)}; hf[3] = (f32x2){bflo(ha.w), bfhi(ha.w)};
                  hf[4] = (f32x2){bflo(hb.x), bfhi(hb.x)}; hf[5] = (f32x2){bflo(hb.y), bfhi(hb.y)}; hf[6] = (f32x2){bflo(hb.z), bfhi(hb.z)}; hf[7] = (f32x2){bflo(hb.w), bfhi(hb.w)}; }
                float v[16];
#pragma unroll
                for (int i = 0; i < 16; ++i) { f32x2 a = (f32x2){0.f, 0.f};
#pragma unroll
                    for (int d = 0; d < 4; ++d) { const unsigned wv = r[i][d]; a += __builtin_amdgcn_cvt_pk_f32_fp8(wv, false) * hf[2 * d]; a += __builtin_amdgcn_cvt_pk_f32_fp8(wv, true) * hf[2 * d + 1]; }
                    v[i] = a.x + a.y; }
                float o0, o1; reduce16to2<1>(v, lane, o0, o1);
                coefl[k * 128 + e0] += o0; coefl[k * 128 + e1] += o1;
            }
        }
#pragma unroll 1
        for (int k = 0; k < 8; ++k)
#pragma unroll
            for (int r2 = 0; r2 < 2; ++r2) { const int e = r2 ? e1 : e0; const float dd = coefl[k * 128 + e] * (1.0f / U8_SCALE) * RSTD[tb + k];
                coefl[k * 128 + e] = PGATE[(size_t)(tb + k) * 128 + e] * 0.5f * dd * (1.0f + erff(dd * 0.70710678118f)) * (1.0f / V8_SCALE); }
        LDS_WAIT(); asm volatile("" ::: "memory");
#pragma unroll 1
        for (int s = 0; s < 16; ++s) {
            const unsigned char* vb = V8 + s * 128 + c * 16;
#pragma unroll 1
            for (int k = 0; k < 8; ++k) {
                const LAS unsigned* ok = offs + k * 128 + eg; const LAS float* ck = coefl + k * 128 + eg;
                u32x4 r[16];
#pragma unroll
                for (int i = 0; i < 16; ++i) r[i] = *(const u32x4*)(vb + ok[8 * i]);
                f32x2 acc[8];
#pragma unroll
                for (int q = 0; q < 8; ++q) acc[q] = (f32x2){0.f, 0.f};
#pragma unroll
                for (int i = 0; i < 16; ++i) { const float cf = ck[8 * i]; const f32x2 cf2 = (f32x2){cf, cf};
#pragma unroll
                    for (int d = 0; d < 4; ++d) { const unsigned wv = r[i][d]; acc[2 * d] += __builtin_amdgcn_cvt_pk_f32_fp8(wv, false) * cf2; acc[2 * d + 1] += __builtin_amdgcn_cvt_pk_f32_fp8(wv, true) * cf2; } }
                float v[16];
#pragma unroll
                for (int q = 0; q < 8; ++q) { v[2 * q] = acc[q].x; v[2 * q + 1] = acc[q].y; }
                float o0, o1; reduce16to2<8>(v, lane, o0, o1);
                const unsigned hw = *(const unsigned*)(HN + (size_t)(tb + k) * 2048 + s * 128 + c * 16 + je);
                *(f32x2*)(C.out + (size_t)(tb + k) * 2048 + s * 128 + c * 16 + je) = (f32x2){bflo(hw) + o0, bfhi(hw) + o1};
            }
        }
        asm volatile("s_waitcnt vmcnt(0)" ::: "memory");
#pragma unroll 1
        for (int k = 0; k < 8; ++k) { f32x4* hr = (f32x4*)(C.out + (size_t)(tb + k) * 2048) + lane; const f32x4* fw = (const f32x4*)C.in(I_FINW) + lane;
            f32x4 x[8]; float ss = 0.f;
#pragma unroll
            for (int j = 0; j < 8; ++j) { x[j] = hr[64 * j]; ss += (x[j].x * x[j].x + x[j].y * x[j].y) + (x[j].z * x[j].z + x[j].w * x[j].w); }
            const float rr = rsqrtf(wave_sum(ss) * (1.0f / 2048.0f) + EPS);
#pragma unroll
            for (int j = 0; j < 8; ++j) hr[64 * j] = x[j] * rr * fw[64 * j]; }
    }
}

__device__ __forceinline__ Ctx phase_ctx(const Ctx& C0) {
    Ctx C = C0; C.ws = launder_s(C0.ws); C.out = launder_s(C0.out);
    unsigned m_ = ~0u; asm volatile("" : "+s"(m_));
    const int l_ = (int)__builtin_amdgcn_mbcnt_hi(m_, __builtin_amdgcn_mbcnt_lo(m_, 0u));
    C.lane = l_; C.tid = C0.wave * 64 + l_; C.wave = C0.wave;
    return C;
}
constexpr int NPH = 16;
__global__ void __launch_bounds__(NTHREADS, 2) mk_fwd(Args args) {
    extern __shared__ __attribute__((aligned(16))) unsigned char lds_raw[];
    Ctx C0; C0.a = &args;
    C0.out = args.out; C0.ws = args.ws; C0.lds = (LAS unsigned char*)lds_raw;
    C0.tid = 0; C0.lane = 0; C0.wave = __builtin_amdgcn_readfirstlane((int)threadIdx.x >> 6); C0.G = gridDim.x; C0.bid = blockIdx.x;
    const int lo = args.ph_lo, hi = args.ph_hi;
    volatile LAS unsigned* xbw = (volatile LAS unsigned*)(C0.lds + LDS_CTL_OFF);
    if (threadIdx.x < 4) xbw[threadIdx.x] = 0u;
    __syncthreads();
    XcdBarrier bar; bar.bar = (unsigned*)(C0.ws + WS_CTL) + CW_BAR; bar.x = 0; bar.st = xbw;
    if (hi - lo > 1) bar = xcd_barrier_post((unsigned*)(C0.ws + WS_CTL) + CW_BAR, xbw);
#define IN(k) (lo <= (k) && (k) < hi)
#define SEAM(k) do { if (IN(k) && IN((k) + 1)) { XcdBarrier b_ = bar; b_.bar = launder_s(bar.bar); xcd_barrier(b_); } } while (0)

    if (IN(0)) { const Ctx C = phase_ctx(C0); p0_prologue(C); __syncthreads(); SEAM(0); }

    for (int hh = 0; hh < NHALVES; ++hh) {
        const int pb = 1 + 6 * hh;
        if (IN(pb + 0)) { const Ctx C = phase_ctx(C0);
            { pg8::Gemm g{launder_s((const bf16_t*)(C.ws + WS_XN) + (size_t)hh * TH * 2048), launder_s((const bf16_t*)(C.ws + WS_WIN_T)), TH, NP1 - 256, 2048};
              pg8::StaticOrder S; S.init(TH, NP1 - 256, C.G, C.bid);
              EpiProj E{C.ws, C.in(I_GATEB), hh};
              pg8::gemm_phase<EpiProj, pg8::StaticOrder, true, true>(C.lds, g, S, E, C.tid); }
            if (hh == 0) {
                asm volatile("s_waitcnt vmcnt(0)" ::: "memory"); __syncthreads();
                pg8::Gemm g{launder_s((const bf16_t*)(C.ws + WS_XN)), launder_s((const bf16_t*)(C.ws + WS_WIN_T) + (size_t)(NP1 - 256) * 2048), T, 256, 2048};
                pg8::StaticOrder S; S.init(T, 256, C.G, C.bid);
                EpiSmall E{(float*)(C.ws + WS_SMALLF)};
                pg8::gemm_phase<EpiSmall, pg8::StaticOrder, true, true>(C.lds, g, S, E, C.tid); }
            SEAM(pb + 0);
        }
        if (IN(pb + 1)) { const Ctx C = phase_ctx(C0); p2_bc_conv(C, hh); gdn_pre(C, hh); SEAM(pb + 1); }
        if (IN(pb + 2)) { const Ctx C = phase_ctx(C0);
            if (C.bid < 64) gdn_scan16(C, hh, C.bid);
            else if (C.bid < 192) ssd_chunked(C, hh, C.bid - 64);
            else if (hh == 0) late_weights(C, 192);
            else tables_to_fp8(C, 192);
            SEAM(pb + 2);
        }
        if (IN(pb + 3)) { const Ctx C = phase_ctx(C0); p4_post(C); SEAM(pb + 3); }
        if (IN(pb + 4)) { const Ctx C = phase_ctx(C0);
            pg8::TwoPassOrder S; S.init(TH, 2048, C.G, C.bid);
            pg8::Gemm g{launder_s((const bf16_t*)(C.ws + WS_ZSSM)), launder_s((const bf16_t*)(C.ws + WS_WBS_T)), TH, 2048, 4096, launder_s((const bf16_t*)(C.ws + WS_ZGDN)), launder_s((const bf16_t*)(C.ws + WS_WBG_T))};
            EpiMixF E{C.ws};
            pg8::gemm_phase<EpiMixF, pg8::TwoPassOrder, true, true>(C.lds, g, S, E, C.tid);
            SEAM(pb + 4);
        }
        if (IN(pb + 5)) { const Ctx C = phase_ctx(C0);
            pg8::Gemm g{launder_s((const bf16_t*)(C.ws + WS_MIXED)), launder_s((const bf16_t*)(C.ws + WS_WOUT_T)), TH, 2048, 2048};
            pg8::StaticOrder S; S.init(TH, 2048, C.G, C.bid);
            EpiOut E{C.in(I_X) + (size_t)hh * TH * 2048, (bf16_t*)(C.ws + WS_XN) + (size_t)hh * TH * 2048, (float*)(C.ws + WS_SSQ) + (size_t)hh * TH * 32};
            pg8::gemm_phase<EpiOut, pg8::StaticOrder, true, true>(C.lds, g, S, E, C.tid);
            SEAM(pb + 5);
        }
    }
    if (IN(13)) { const Ctx C = phase_ctx(C0);
        pg8::Gemm g{launder_s((const bf16_t*)(C.ws + WS_XN)), launder_s((const bf16_t*)(C.ws + WS_WQ_T)), T, 2048, 2048};
        pg8::StaticOrder S; S.init(T, 2048, C.G, C.bid);
        EpiQ E{(bf16_t*)(C.ws + WS_Q)};
        pg8::gemm_phase<EpiQ, pg8::StaticOrder, true, true>(C.lds, g, S, E, C.tid);
        SEAM(13);
    }
    if (IN(14)) { const Ctx C = phase_ctx(C0); p9_scores(C); SEAM(14); }
    if (IN(15)) { const Ctx C = phase_ctx(C0); p10_peer_sliced(C); }
#undef IN
#undef SEAM
}
}

extern "C" void kernel_launch(void* const* d_in, const int* in_sizes, int n_in, void* d_out, int out_size, void* d_ws, size_t ws_size, hipStream_t stream) {
    using namespace mk;
    static int grid = 0;
    if (grid == 0) {
        if (n_in != N_IN || out_size != T * D || ws_size < WS_NEED) { fprintf(stderr, "kernel_launch: unexpected problem (n_in %d out %d ws %zu)\n", n_in, out_size, ws_size); grid = -1; return; }
        int dev = 0, cus = 0, per_cu = 0;
        if (hipGetDevice(&dev) != hipSuccess || hipDeviceGetAttribute(&cus, hipDeviceAttributeMultiprocessorCount, dev) != hipSuccess) { grid = -1; return; }
        if (hipFuncSetAttribute((const void*)mk_fwd, hipFuncAttributeMaxDynamicSharedMemorySize, LDS_BYTES) != hipSuccess) { fprintf(stderr, "kernel_launch: hipFuncSetAttribute failed\n"); grid = -1; return; }
        if (hipOccupancyMaxActiveBlocksPerMultiprocessor(&per_cu, (const void*)mk_fwd, NTHREADS, LDS_BYTES) != hipSuccess || per_cu < 1) fprintf(stderr, "kernel_launch: occupancy query says %d\n", per_cu);
        (void)hipGetLastError();
        grid = cus;
        if (grid < 192) { fprintf(stderr, "kernel_launch: %d CUs; the scan phase needs 192 resident workgroups\n", grid); grid = -1; return; }
    }
    if (grid < 0) return;
    (void)hipMemsetAsync((char*)d_ws + WS_CTL, 0, CTL_ZERO_BYTES, stream);
    Args a{};
    for (int i = 0; i < N_IN; ++i) a.in[i] = (const float*)d_in[i];
    a.out = (float*)d_out; a.ws = (unsigned char*)d_ws;
#if MK_ONE_LAUNCH
    a.ph_lo = 0; a.ph_hi = NPH;
    hipLaunchKernelGGL(mk_fwd, dim3(grid), dim3(NTHREADS), LDS_BYTES, stream, a);
#else
    for (int ph = 0; ph < NPH; ++ph) { a.ph_lo = ph; a.ph_hi = ph + 1; hipLaunchKernelGGL(mk_fwd, dim3(grid), dim3(NTHREADS), LDS_BYTES, stream, a); }
#endif
}
```

```cpp
#include <hip/hip_runtime.h>
#include <cstdio>
#include <cstdint>
#include <cmath>
namespace pg8 {
#define PG8_LAS __attribute__((address_space(3)))
typedef unsigned short bf16_t;
typedef short bf16x8 __attribute__((ext_vector_type(8)));
typedef float f32x4 __attribute__((ext_vector_type(4)));
typedef unsigned u32x4 __attribute__((ext_vector_type(4)));
constexpr int BM = 256, BK = 64, HALF = 128, HTB = HALF * BK * 2  , STAGE_BYTES = 8 * HTB, NXCD = 8, WGM = 4;

__host__ __device__ __forceinline__ int lds_byte(int r, int c) { const int st = (r >> 4) * 2 + (c >> 5), rr = r & 15, cc = c & 31, ob = rr * 64 + cc * 2; return st * 1024 + (ob ^ (((ob >> 9) & 1) << 5)); }
__host__ __device__ __forceinline__ void stage_rc(int b, int& R, int& C) { const int st = b / 1024, sb = b % 1024, swz = sb ^ (((sb >> 9) & 1) << 5); R = (st >> 1) * 16 + swz / 64; C = (st & 1) * 32 + (swz % 64) / 2; }
__host__ __device__ __forceinline__ int perm32(int rho) { const int n = rho >> 4, i = rho & 15; return 8 * (i >> 2) + 4 * n + (i & 3); }

struct Unit { int pm, pn, z; };
struct Gemm { const bf16_t* A; const bf16_t* Bt; int M, N, K; const bf16_t* A2 = nullptr; const bf16_t* Bt2 = nullptr; };

struct StaticOrder {
    int nM, nN, nwg, G, c;
    __host__ __device__ void init(int M, int N, int G_, int c_) { nM = M / BM; nN = N / BM; nwg = nM * nN; G = G_; c = c_; }
    __host__ __device__ bool next(int i, Unit& u) const {
        const long L = (long)i * G + c; if (L >= nwg) return false;
        int wgid = (int)L; { const int q = nwg / NXCD, r = nwg % NXCD, xcd = wgid % NXCD, off = wgid / NXCD; wgid = (xcd < r ? xcd * (q + 1) : r * (q + 1) + (xcd - r) * q) + off; }
        const int nig = WGM * nN, gid = wgid / nig, fm = gid * WGM, gsz = (nM - fm) < WGM ? (nM - fm) : WGM;
        u.pm = fm + ((wgid % nig) % gsz); u.pn = (wgid % nig) / gsz; u.z = 0; return true;
    }
    __device__ __forceinline__ void a_ready(const Unit&) const {}
    __device__ __forceinline__ void done(const Unit&) const {}
};
struct TwoPassOrder {
    StaticOrder o;
    __host__ __device__ void init(int M, int N, int G_, int c_) { o.init(M, N, G_, c_); }
    __host__ __device__ bool next(int i, Unit& u) const { if (!o.next(i >> 1, u)) return false; u.z = i & 1; return true; }
    __device__ __forceinline__ void a_ready(const Unit&) const {}
    __device__ __forceinline__ void done(const Unit&) const {}
};
__device__ __forceinline__ unsigned cvt_pk_bf16(float lo, float hi) { unsigned r; asm volatile("v_cvt_pk_bf16_f32 %0, %1, %2" : "=v"(r) : "v"(lo), "v"(hi)); return r; }
typedef float f32x2 __attribute__((ext_vector_type(2)));
__device__ __forceinline__ f32x2 gelu_pk(f32x2 v) {
    const f32x2 av = __builtin_elementwise_abs(v), d = av * 0.2316418882f + 1.0f;
    f32x2 t; t.x = __builtin_amdgcn_rcpf(d.x); t.y = __builtin_amdgcn_rcpf(d.y);
    f32x2 q = t * 0.5307027145f + (-0.7265760135f); q = q * t + 0.7107068705f; q = q * t + (-0.142248368f); q = q * t + 0.127414796f; q = q * t;
    const f32x2 s = (v * v) * (-0.72134752044f);
    f32x2 e; e.x = __builtin_amdgcn_exp2f(s.x); e.y = __builtin_amdgcn_exp2f(s.y);
    const f32x2 m = v * (q * e), r = v - m;
    f32x2 o; o.x = v.x < 0.f ? m.x : r.x; o.y = v.y < 0.f ? m.y : r.y; return o;
}
template <class Epi, class Sched, bool ALIGN_EPI = false, bool SP2 = false>
__device__ __forceinline__ void gemm_phase(PG8_LAS unsigned char* lds, const Gemm g, const Sched& S, const Epi& E, int tid_in) {
    int tid_ = tid_in; asm volatile("" : "+v"(tid_));
    const int tid = tid_, wid = __builtin_amdgcn_readfirstlane(tid >> 6), lane = tid & 63, wr = wid >> 2, wc = wid & 3, fr = lane & 15, fq = lane >> 4;
    const int K = g.K, nt = K / BK;
    unsigned voffA[2], voffB[2];
#pragma unroll
    for (int i = 0; i < 2; ++i) { int R, C; stage_rc(tid * 16 + i * 8192, R, C); const int Rb = Epi::PERM ? ((R & ~31) + perm32(R & 31)) : R;
        voffA[i] = (unsigned)(R * K + C) * 2u; voffB[i] = (unsigned)(Rb * K + C) * 2u; }
    const size_t kstep = (size_t)(BK * 2);
    const size_t hstep = (size_t)HALF * K * 2;
    const size_t tstep = 2 * hstep;
    const unsigned ldsw = (unsigned)wid * 1024u;
    const int aoff = lds_byte(wr * 64 + fr, fq * 8), boff = lds_byte(wc * 32 + fr, fq * 8);
#define PG8_SA(b, h) (((b) * 2 + (h)) * HTB)
#define PG8_SB(b, h) ((4 + (b) * 2 + (h)) * HTB)
#define PG8_STAGE(bufoff, gbase, voff) do { _Pragma("unroll") for (int _i = 0; _i < 2; ++_i) \
        __builtin_amdgcn_global_load_lds((const unsigned*)((const char*)(gbase) + (voff)[_i]), (PG8_LAS unsigned*)(lds + (bufoff) + ldsw + _i * 8192), 16, 0, 0); } while (0)
#define PG8_LDA(dst, b, h) do { _Pragma("unroll") for (int m = 0; m < 4; ++m) _Pragma("unroll") for (int k = 0; k < 2; ++k) dst[m][k] = *(const PG8_LAS bf16x8*)(lds + PG8_SA(b, h) + aoff + m * 2048 + k * 1024); } while (0)
#define PG8_LDB(dst, b, h) do { _Pragma("unroll") for (int n = 0; n < 2; ++n) _Pragma("unroll") for (int k = 0; k < 2; ++k) dst[n][k] = *(const PG8_LAS bf16x8*)(lds + PG8_SB(b, h) + boff + n * 2048 + k * 1024); } while (0)
#define PG8_MMA(ai, bj, At, Bt) do { __builtin_amdgcn_s_setprio(1); _Pragma("unroll") for (int m = 0; m < 4; ++m) _Pragma("unroll") for (int n = 0; n < 2; ++n) _Pragma("unroll") for (int k = 0; k < 2; ++k) \
        acc[ai][bj][m][n] = __builtin_amdgcn_mfma_f32_16x16x32_bf16(Bt[n][k], At[m][k], acc[ai][bj][m][n], 0, 0, 0); __builtin_amdgcn_s_setprio(0); } while (0)
#define PG8_WAIT_V(n) asm volatile("s_waitcnt vmcnt(" #n ")" ::: "memory")
#define PG8_WAIT_L(n) asm volatile("s_waitcnt lgkmcnt(" #n ")" ::: "memory")
#define PG8_BAR __builtin_amdgcn_s_barrier()
#define PG8_SCHED __builtin_amdgcn_sched_barrier(0)
    Unit cur, nxt; int ui = 0;
    if (!S.next(0, cur)) return;
    f32x4 acc[2][2][4][2];
#pragma unroll
    for (int a = 0; a < 2; ++a)
#pragma unroll
        for (int b = 0; b < 2; ++b)
#pragma unroll
            for (int m = 0; m < 4; ++m)
#pragma unroll
                for (int n = 0; n < 2; ++n) acc[a][b][m][n] = (f32x4){0.f, 0.f, 0.f, 0.f};
    bf16x8 At[4][2], B0[2][2], B1[2][2];
    const char* cA = (const char*)((Epi::TWO_PASS && cur.z) ? g.A2 : g.A) + (size_t)cur.pm * tstep; const char* cB = (const char*)((Epi::TWO_PASS && cur.z) ? g.Bt2 : g.Bt) + (size_t)cur.pn * tstep;
    S.a_ready(cur);
    if constexpr (SP2) {
        PG8_STAGE(PG8_SB(0, 0), cB, voffB); PG8_STAGE(PG8_SB(0, 1), cB + hstep, voffB); PG8_STAGE(PG8_SA(0, 0), cA, voffA); PG8_STAGE(PG8_SA(0, 1), cA + hstep, voffA);
        if (wr == 1) PG8_BAR;
        PG8_WAIT_V(2); PG8_BAR;
        PG8_STAGE(PG8_SB(1, 0), cB + kstep, voffB); PG8_STAGE(PG8_SA(1, 0), cA + kstep, voffA); PG8_STAGE(PG8_SB(1, 1), cB + hstep + kstep, voffB);
        PG8_WAIT_V(6); PG8_BAR;
    } else {
        PG8_STAGE(PG8_SB(0, 0), cB, voffB); PG8_STAGE(PG8_SA(0, 0), cA, voffA); PG8_STAGE(PG8_SB(0, 1), cB + hstep, voffB); PG8_STAGE(PG8_SA(0, 1), cA + hstep, voffA);
        if (wr == 1) PG8_BAR;
        PG8_WAIT_V(4); PG8_BAR;
        PG8_STAGE(PG8_SB(1, 0), cB + kstep, voffB); PG8_STAGE(PG8_SA(1, 0), cA + kstep, voffA); PG8_STAGE(PG8_SB(1, 1), cB + hstep + kstep, voffB);
        PG8_WAIT_V(6); PG8_BAR;
    }
    for (;;) {
        const bool has_next = S.next(ui + 1, nxt);
        const char* nA = has_next ? (const char*)((Epi::TWO_PASS && nxt.z) ? g.A2 : g.A) + (size_t)nxt.pm * tstep : cA; const char* nB = has_next ? (const char*)((Epi::TWO_PASS && nxt.z) ? g.Bt2 : g.Bt) + (size_t)nxt.pn * tstep : cB;
        for (int t = 0; t < nt; t += 2) {
            const bool last = (t == nt - 2);
            const char* a1 = cA + (size_t)(t + 1) * kstep;
            const char* a2 = last ? nA : cA + (size_t)(t + 2) * kstep; const char* b2 = last ? nB : cB + (size_t)(t + 2) * kstep;
            const char* a3 = a2 + kstep; const char* b3 = b2 + kstep;
            if (last && has_next) S.a_ready(nxt);
            if constexpr (SP2) {
            PG8_LDB(B0, 0, 0); PG8_LDB(B1, 0, 1); PG8_SCHED; PG8_LDA(At, 0, 0); PG8_STAGE(PG8_SA(1, 1), a1 + hstep, voffA);
            PG8_WAIT_V(8); PG8_WAIT_L(0); PG8_BAR; PG8_MMA(0, 0, At, B0); PG8_MMA(0, 1, At, B1); PG8_BAR; PG8_SCHED;
            PG8_LDA(At, 0, 1); PG8_STAGE(PG8_SB(0, 0), b2, voffB); PG8_STAGE(PG8_SB(0, 1), b2 + hstep, voffB); PG8_STAGE(PG8_SA(0, 0), a2, voffA);
            PG8_WAIT_V(8); PG8_WAIT_L(0); PG8_BAR; PG8_MMA(1, 0, At, B0); PG8_MMA(1, 1, At, B1); PG8_BAR; PG8_SCHED;
            PG8_LDB(B0, 1, 0); PG8_LDB(B1, 1, 1); PG8_SCHED; PG8_LDA(At, 1, 0); PG8_STAGE(PG8_SA(0, 1), a2 + hstep, voffA);
            PG8_WAIT_V(8); PG8_WAIT_L(0); PG8_BAR; PG8_MMA(0, 0, At, B0); PG8_MMA(0, 1, At, B1); PG8_BAR; PG8_SCHED;
            PG8_LDA(At, 1, 1); PG8_STAGE(PG8_SB(1, 0), b3, voffB); PG8_STAGE(PG8_SB(1, 1), b3 + hstep, voffB); PG8_STAGE(PG8_SA(1, 0), a3, voffA);
            PG8_WAIT_V(8); PG8_WAIT_L(0); PG8_BAR; PG8_MMA(1, 0, At, B0); PG8_MMA(1, 1, At, B1); PG8_BAR; PG8_SCHED;
            } else {
            PG8_LDB(B0, 0, 0); PG8_SCHED; PG8_LDA(At, 0, 0); PG8_STAGE(PG8_SA(1, 1), a1 + hstep, voffA);
            PG8_WAIT_L(8); PG8_BAR; PG8_WAIT_L(0); PG8_MMA(0, 0, At, B0); PG8_BAR; PG8_SCHED;
            PG8_LDB(B1, 0, 1); PG8_STAGE(PG8_SB(0, 0), b2, voffB);
            PG8_BAR; PG8_WAIT_L(0); PG8_MMA(0, 1, At, B1); PG8_BAR;
            PG8_LDA(At, 0, 1); PG8_STAGE(PG8_SA(0, 0), a2, voffA);
            PG8_BAR; PG8_WAIT_L(0); PG8_MMA(1, 0, At, B0); PG8_BAR; PG8_SCHED;
            PG8_STAGE(PG8_SB(0, 1), b2 + hstep, voffB);
            PG8_WAIT_V(6); PG8_BAR; PG8_MMA(1, 1, At, B1); PG8_BAR;
            PG8_LDB(B0, 1, 0); PG8_SCHED; PG8_LDA(At, 1, 0); PG8_STAGE(PG8_SA(0, 1), a2 + hstep, voffA);
            PG8_WAIT_L(8); PG8_BAR; PG8_WAIT_L(0); PG8_MMA(0, 0, At, B0); PG8_BAR; PG8_SCHED;
            PG8_LDB(B1, 1, 1); PG8_STAGE(PG8_SB(1, 0), b3, voffB);
            PG8_BAR; PG8_WAIT_L(0); PG8_MMA(0, 1, At, B1); PG8_BAR;
            PG8_LDA(At, 1, 1); PG8_STAGE(PG8_SA(1, 0), a3, voffA);
            PG8_BAR; PG8_WAIT_L(0); PG8_MMA(1, 0, At, B0); PG8_BAR; PG8_SCHED;
            PG8_STAGE(PG8_SB(1, 1), b3 + hstep, voffB);
            PG8_WAIT_V(6); PG8_BAR; PG8_MMA(1, 1, At, B1); PG8_BAR;
            }
        }
        if constexpr (ALIGN_EPI) { if (wr == 0) PG8_BAR; }
        bool keep_acc = false;
        if constexpr (Epi::TWO_PASS) { if (cur.z == 0) { E.mid(acc, cur, wr, wc, fr, fq); keep_acc = true; } else { E(acc, cur, wr, wc, fr, fq); S.done(cur); } }
        else if constexpr (!Epi::AFTER_DRAIN) { E(acc, cur, wr, wc, fr, fq); S.done(cur); }
        if (!has_next) break;
        if (!keep_acc)
#pragma unroll
        for (int a = 0; a < 2; ++a)
#pragma unroll
            for (int b = 0; b < 2; ++b)
#pragma unroll
                for (int m = 0; m < 4; ++m)
#pragma unroll
                    for (int n = 0; n < 2; ++n) acc[a][b][m][n] = (f32x4){0.f, 0.f, 0.f, 0.f};
        cur = nxt; cA = nA; cB = nB; ++ui;
        if constexpr (ALIGN_EPI) { if (wr == 1) PG8_BAR; }
    }
    PG8_WAIT_V(0);
    if constexpr (!ALIGN_EPI) { if (wr == 0) PG8_BAR; }
    PG8_BAR;
    if constexpr (Epi::AFTER_DRAIN) { E.fused(acc, cur, wr, wc, fr, fq, lds, wid, lane); S.done(cur); }
#undef PG8_SA
#undef PG8_SB
#undef PG8_STAGE
#undef PG8_LDA
#undef PG8_LDB
#undef PG8_MMA
#undef PG8_WAIT_V
#undef PG8_WAIT_L
#undef PG8_BAR
#undef PG8_SCHED
}
}

#define XB_TMO      128
#define XB_XCNT(j)  (256  + 64 * (j))
#define XB_XSUB(j)  (1280 + 64 * (j))
#define XB_XGEN(j)  (2304 + 64 * (j))
#define XB_TOP      3328
#define XB_TOPGEN   3392
#define XCD_BAR_WORDS 3456
#define XB_SPIN_CAP (1u << 18)
#define LAS __attribute__((address_space(3)))

__device__ __forceinline__ unsigned xb_ld(unsigned* p)              { return __hip_atomic_load(p, __ATOMIC_RELAXED, __HIP_MEMORY_SCOPE_AGENT); }
__device__ __forceinline__ unsigned xb_add(unsigned* p, unsigned v) { return __hip_atomic_fetch_add(p, v, __ATOMIC_RELAXED, __HIP_MEMORY_SCOPE_AGENT); }
__device__ __forceinline__ unsigned xb_xcc_id() { return (unsigned)__builtin_amdgcn_s_getreg((3 << 11) | 20) & 0xFu; }
#define XB_SPIN(cond, bar) do { unsigned _sp = 0; while (cond) { __builtin_amdgcn_s_sleep(1); \
    if ((++_sp & 255u) == 0u) { if (xb_ld(&(bar)[XB_TMO])) break; if (_sp > XB_SPIN_CAP) { atomicAdd(&(bar)[XB_TMO], 1u); break; } } } } while (0)

struct XcdBarrier {
    unsigned* bar; unsigned x;
    volatile LAS unsigned* st;
};

__device__ __forceinline__ XcdBarrier xcd_barrier_post(unsigned* bar, volatile LAS unsigned* st) {
    XcdBarrier b; b.bar = bar; b.x = xb_xcc_id(); b.st = st;
    if (threadIdx.x == 0) (void)xb_add(&bar[XB_XCNT(b.x)], 1u);
    return b;
}
__device__ __forceinline__ void xcd_barrier_complete(unsigned* bar, unsigned x, unsigned& nloc, unsigned& nx) {
    const unsigned G = gridDim.x * gridDim.y * gridDim.z;
    unsigned sum, cnt, mine, sp = 0u;
    for (;;) {
        sum = 0u; cnt = 0u; mine = 0u;
#pragma unroll
        for (unsigned j = 0; j < 16; ++j) { const unsigned c = xb_ld(&bar[XB_XCNT(j)]); sum += c; cnt += (c > 0u) ? 1u : 0u; mine = (j == x) ? c : mine; }
        if (sum == G) break;
        __builtin_amdgcn_s_sleep(1);
        if ((++sp & 255u) == 0u) { if (xb_ld(&bar[XB_TMO])) break; if (sp > XB_SPIN_CAP) { atomicAdd(&bar[XB_TMO], 1u); break; } }
    }
    nloc = mine > 0u ? mine : 1u; nx = cnt > 0u ? cnt : 1u;
}

__device__ __forceinline__ void xcd_barrier(const XcdBarrier& b) {
    asm volatile("s_waitcnt vmcnt(0)" ::: "memory");
    __syncthreads();
    if (threadIdx.x == 0) {
        unsigned* bar = b.bar;
        __builtin_amdgcn_s_waitcnt(0);
        unsigned nloc = b.st[0], nx = b.st[1];
        if (nloc == 0u) { xcd_barrier_complete(bar, b.x, nloc, nx); b.st[0] = nloc; b.st[1] = nx; }
        const unsigned old = xb_add(&bar[XB_XSUB(b.x)], 1u);
        const unsigned gen = old / nloc;
        if (old + 1u == (gen + 1u) * nloc) {
            __builtin_amdgcn_fence(__ATOMIC_RELEASE, "agent");
            asm volatile("s_waitcnt vmcnt(0)" ::: "memory");
            const unsigned og = xb_add(&bar[XB_TOP], 1u);
            const unsigned tg = og / nx;
            if (og + 1u == (tg + 1u) * nx) xb_add(&bar[XB_TOPGEN], 1u);
            else XB_SPIN(xb_ld(&bar[XB_TOPGEN]) == tg, bar);
            __builtin_amdgcn_fence(__ATOMIC_ACQUIRE, "agent");
            xb_add(&bar[XB_XGEN(b.x)], 1u);
            asm volatile("s_waitcnt vmcnt(0)" ::: "memory");
        } else {
            XB_SPIN(xb_ld(&bar[XB_XGEN(b.x)]) == gen, bar);
            __builtin_amdgcn_fence(__ATOMIC_ACQUIRE, "agent");
            asm volatile("s_waitcnt vmcnt(0)" ::: "memory");
        }
    }
    __syncthreads();
}

namespace mk {
using pg8::bf16_t; using pg8::f32x4; using pg8::u32x4; using pg8::bf16x8; using pg8::Unit; using pg8::cvt_pk_bf16;
typedef unsigned u32x2 __attribute__((ext_vector_type(2)));

#ifndef MK_ONE_LAUNCH
#define MK_ONE_LAUNCH 1
#endif

constexpr int T = 16384, D = 2048, TH = 8192, NHALVES = 2;
constexpr int NWAVES = 8, NTHREADS = 512;
constexpr float EPS = 1e-6f;
enum { I_X = 0, I_MIXNW, I_WIN, I_GATEB, I_SCW, I_SCB, I_SDTB, I_SALOG, I_SD, I_SNW, I_GCW, I_GDTB, I_GALOG, I_GNW, I_WBS, I_WBG, I_WOUT, I_FNW, I_WQ, I_SK, I_PU, I_PV, I_FINW, N_IN };
constexpr int IN_PROJ = 26720;
constexpr int NP1 = 26880;

constexpr size_t MiB = 1u << 20;
constexpr size_t WS_CTL = 0, CTL_ZERO_BYTES = 1 * MiB;
constexpr size_t WS_WIN_T = 1 * MiB;
constexpr size_t WS_WBS_T = WS_WIN_T + (size_t)NP1 * 2048 * 2;
constexpr size_t WS_WBG_T = WS_WBS_T + 16 * MiB;
constexpr size_t WS_WOUT_T = WS_WBG_T + 16 * MiB;
constexpr size_t WS_WQ_T = WS_WOUT_T + 8 * MiB;
constexpr size_t WS_SKB = WS_WQ_T + 8 * MiB;
constexpr size_t WS_XN = WS_SKB + 1 * MiB;
constexpr size_t WS_HALF = WS_XN + 64 * MiB;
constexpr size_t WS_ZSSM = WS_HALF;
constexpr size_t WS_XBC = WS_ZSSM + 64 * MiB;
constexpr size_t WS_QKV = WS_XBC + 96 * MiB;
constexpr size_t WS_ZGDN = WS_QKV + 128 * MiB;
constexpr size_t WS_GATES = WS_ZGDN + 64 * MiB;
constexpr size_t WS_SMALL = WS_GATES + 64 * MiB;
constexpr size_t WS_SSQ = WS_SMALL;
constexpr size_t WS_RSTD = WS_SMALL + 2 * MiB;
constexpr size_t WS_MIXED = WS_XBC;
constexpr size_t WS_BCCONV = WS_SMALL + 4 * MiB;
constexpr size_t WS_HALO_XBC = WS_BCCONV + 32 * MiB;
constexpr size_t WS_HALO_QKV = WS_HALO_XBC + 9 * MiB;
constexpr size_t WS_ST_SSD = WS_HALO_QKV + 12 * MiB;
constexpr size_t WS_ST_GDN = WS_ST_SSD + 2 * MiB;
constexpr size_t WS_GW = WS_ST_GDN + 2 * MiB;
constexpr size_t WS_GATT = WS_GW + 32 * MiB;
constexpr size_t WS_U8 = WS_GATT + 16 * MiB;
constexpr size_t WS_V8 = WS_U8 + 32 * MiB;
constexpr size_t WS_GCD = WS_V8 + 32 * MiB;
constexpr size_t WS_SMALLF = WS_GCD + 1 * MiB;
constexpr size_t WS_HALF_END = WS_SMALLF + 8 * MiB;
constexpr size_t WS_Q = WS_HALF;
constexpr size_t WS_PIDX = WS_Q + 64 * MiB;
constexpr size_t WS_PGATE = WS_PIDX + 8 * MiB;
constexpr size_t WS_NEED = WS_HALF_END;
static_assert(WS_PGATE + 8 * MiB <= WS_U8, "q / idx / gate overlay only buffers that are dead after the mixer, below the fp8 tables");
static_assert(WS_NEED <= 835 * MiB, "workspace map exceeds 835 MiB");

constexpr int CW_BAR = 4096;
constexpr int LDS_BYTES = 147456;
constexpr int LDS_CTL_OFF = LDS_BYTES - 256;

__device__ __forceinline__ float bf2f(unsigned short b) { return __uint_as_float(((unsigned)b) << 16); }
__device__ __forceinline__ float bflo(unsigned w) { return __uint_as_float(w << 16); }
__device__ __forceinline__ float bfhi(unsigned w) { return __uint_as_float(w & 0xffff0000u); }
typedef __bf16 bf16v2 __attribute__((ext_vector_type(2)));
typedef float f32x2 __attribute__((ext_vector_type(2)));
__device__ __forceinline__ unsigned pkc(float lo, float hi) { return __builtin_bit_cast(unsigned, __builtin_convertvector((f32x2){lo, hi}, bf16v2)); }
__device__ __forceinline__ unsigned f2bf(float f) { return pkc(f, 0.f) & 0xffffu; }
__device__ __forceinline__ unsigned pk2(float lo, float hi) { return pkc(lo, hi); }
__device__ __forceinline__ float wave_sum(float v) {
#pragma unroll
    for (int o = 1; o < 64; o <<= 1) v += __shfl_xor(v, o);
    return v;
}
__device__ __forceinline__ float sigmoidf_(float x) { return __builtin_amdgcn_rcpf(1.0f + __expf(-x)); }
__device__ __forceinline__ float siluf_(float x) { return x * __builtin_amdgcn_rcpf(1.0f + __expf(-x)); }
__device__ __forceinline__ float softplusf_(float x) {
    const float e = __expf(x); const float s = e * (1.0f + e * (-0.5f + e * (0.33333333f - 0.25f * e)));
    return x > 15.f ? x : (e < 0.03f ? s : __logf(1.0f + e)); }
#define LDS_WAIT() asm volatile("s_waitcnt lgkmcnt(0)" ::: "memory")
#define GAS __attribute__((address_space(1)))
template <class P> __device__ __forceinline__ P* launder_s(P* p) { GAS P* g = (GAS P*)p; asm volatile("" : "+s"(g)); return (P*)g; }

struct Args { const float* in[N_IN]; float* out; unsigned char* ws; int ph_lo, ph_hi; };
static_assert(sizeof(Args) == (N_IN + 2) * 8 + 8, "Args has padding");
struct Ctx {
    const Args* a; float* out; unsigned char* ws;
    LAS unsigned char* lds; int tid, lane, wave, G, bid;
    __device__ __forceinline__ const float* in(int i) const { return (const float*)(const GAS float*)a->in[i]; }
};

__device__ __forceinline__ void transpose_item(const float* W, int ldw, int src_col0, bf16_t* WT, int K, int dst_row0, int k0, LAS float* scr, int lane, const float* ksc = nullptr) {
    float tv[32];
#pragma unroll
    for (int i = 0; i < 32; ++i) tv[i] = W[(size_t)(k0 + 2 * i + (lane >> 5)) * ldw + src_col0 + (lane & 31)];
    if (ksc != nullptr) {
#pragma unroll
        for (int i = 0; i < 32; ++i) tv[i] *= ksc[k0 + 2 * i + (lane >> 5)]; }
#pragma unroll
    for (int i = 0; i < 32; ++i) scr[(2 * i + (lane >> 5)) * 33 + (lane & 31)] = tv[i];
    LDS_WAIT(); asm volatile("" ::: "memory");
    const int c = lane & 7;
#pragma unroll
    for (int j = 0; j < 4; ++j) { const int n = (lane >> 3) + 8 * j; const LAS float* s = scr + (8 * c) * 33 + n;
        u32x4 o; o.x = pk2(s[0 * 33], s[1 * 33]); o.y = pk2(s[2 * 33], s[3 * 33]); o.z = pk2(s[4 * 33], s[5 * 33]); o.w = pk2(s[6 * 33], s[7 * 33]);
        *(u32x4*)(WT + (size_t)(dst_row0 + n) * K + k0 + 8 * c) = o; }
    LDS_WAIT(); asm volatile("" ::: "memory");
}
__device__ __forceinline__ bool seg_do(int& r, const float* W, int ldw, int src_col0, int ncols, bf16_t* WT, int K, int dst_row0, LAS float* scr, int lane, const float* ksc = nullptr) {
    const int nblk = ncols / 32, items = (K / 64) * nblk;
    if (r < items) { const int kb = r / nblk, nb = r % nblk; transpose_item(W, ldw, src_col0 + 32 * nb, WT, K, dst_row0 + 32 * nb, 64 * kb, scr, lane, ksc); return true; }
    r -= items; return false;
}
__device__ __forceinline__ void rms_row_to_bf16(const float* xrow, const float* w, bf16_t* orow, int lane) {
    const f32x4* xr = (const f32x4*)xrow + 2 * lane; f32x4 v[8]; float s = 0.f;
#pragma unroll
    for (int j = 0; j < 4; ++j) { v[2 * j] = xr[128 * j]; v[2 * j + 1] = xr[128 * j + 1]; }
#pragma unroll
    for (int j = 0; j < 8; ++j) s += (v[j].x * v[j].x + v[j].y * v[j].y) + (v[j].z * v[j].z + v[j].w * v[j].w);
    const float r = rsqrtf(wave_sum(s) * (1.0f / 2048.0f) + EPS);
    const f32x4* wr = (const f32x4*)w + 2 * lane; u32x4* o16 = (u32x4*)orow + lane;
#pragma unroll
    for (int j = 0; j < 4; ++j) { const f32x4 g0 = wr[128 * j], g1 = wr[128 * j + 1], a = v[2 * j], b = v[2 * j + 1]; u32x4 o;
        o.x = pk2(a.x * r * g0.x, a.y * r * g0.y); o.y = pk2(a.z * r * g0.z, a.w * r * g0.w); o.z = pk2(b.x * r * g1.x, b.y * r * g1.y); o.w = pk2(b.z * r * g1.z, b.w * r * g1.w);
        o16[64 * j] = o; }
}
__device__ __forceinline__ void late_weights(const Ctx& C, int first_wg) {
    LAS float* scr = (LAS float*)(C.lds + C.wave * 16384);
    const int gw = (C.bid - first_wg) * NWAVES + C.wave, NGW = (C.G - first_wg) * NWAVES;
    for (int it = gw; it < 4096 + 4096 + 2048 + 2048; it += NGW) {
        int r = it;
        if (seg_do(r, C.in(I_WBS), 2048, 0, 2048, (bf16_t*)(C.ws + WS_WBS_T), 4096, 0, scr, C.lane)) continue;
        if (seg_do(r, C.in(I_WBG), 2048, 0, 2048, (bf16_t*)(C.ws + WS_WBG_T), 4096, 0, scr, C.lane)) continue;
        if (seg_do(r, C.in(I_WOUT), 2048, 0, 2048, (bf16_t*)(C.ws + WS_WOUT_T), 2048, 0, scr, C.lane)) continue;
        seg_do(r, C.in(I_WQ), 2048, 0, 2048, (bf16_t*)(C.ws + WS_WQ_T), 2048, 0, scr, C.lane, C.in(I_FNW));
    }
}
__device__ __forceinline__ void p0_prologue(const Ctx& C) {
    LAS float* scr = (LAS float*)(C.lds + C.wave * 16384);
    const int gw = C.bid * NWAVES + C.wave, NGW = C.G * NWAVES;
    bf16_t* WinT = (bf16_t*)(C.ws + WS_WIN_T);
    constexpr int NITEMS = 32 * (320 + 384 + 128 + 2 + 1);
    for (int it = gw; it < NITEMS; it += NGW) {
        int r = it;
        if (seg_do(r, C.in(I_WIN), IN_PROJ, 0, 10240, WinT, 2048, 0, scr, C.lane)) continue;
        if (seg_do(r, C.in(I_WIN), IN_PROJ, 10304, 12288, WinT, 2048, 10240, scr, C.lane)) continue;
        if (seg_do(r, C.in(I_WIN), IN_PROJ, 22624, 4096, WinT, 2048, 22528, scr, C.lane)) continue;
        if (seg_do(r, C.in(I_WIN), IN_PROJ, 10240, 64, WinT, 2048, 26624, scr, C.lane)) continue;
        seg_do(r, C.in(I_WIN), IN_PROJ, 22592, 32, WinT, 2048, 26688, scr, C.lane);
    }
    const int gt = C.bid * NTHREADS + C.tid, NGT = C.G * NTHREADS;
    { u32x4* z = (u32x4*)(WinT + (size_t)26720 * 2048); for (int i = gt; i < 160 * 2048 / 8; i += NGT) z[i] = (u32x4){0u, 0u, 0u, 0u}; }
    { u32x4* z = (u32x4*)(C.ws + WS_ST_SSD); for (int i = gt; i < (int)(4 * MiB / 16); i += NGT) z[i] = (u32x4){0u, 0u, 0u, 0u}; }
    { const float* sk = C.in(I_SK); unsigned* o = (unsigned*)(C.ws + WS_SKB); for (int i = gt; i < 8 * 2 * 128 * 128 / 2; i += NGT) o[i] = pk2(sk[2 * i], sk[2 * i + 1]); }
    bf16_t* XN = (bf16_t*)(C.ws + WS_XN);
    for (int m = gw; m < T; m += NGW) rms_row_to_bf16(C.in(I_X) + (size_t)m * D, C.in(I_MIXNW), XN + (size_t)m * D, C.lane);
}

__device__ __forceinline__ void unpack8(const u32x4 v, float (&f)[8]) { f[0] = bflo(v.x); f[1] = bfhi(v.x); f[2] = bflo(v.y); f[3] = bfhi(v.y); f[4] = bflo(v.z); f[5] = bfhi(v.z); f[6] = bflo(v.w); f[7] = bfhi(v.w); }
struct EpiProj {
    static constexpr bool PERM = true, AFTER_DRAIN = false; static constexpr bool TWO_PASS = false;
    unsigned char* ws; const float* gate_b; int hh;
    __device__ __forceinline__ void operator()(const f32x4 (&acc)[2][2][4][2], const Unit& u, int wr, int wc, int fr, int fq) const {
        { int z_ = 0; asm volatile("" : "+v"(z_)); fr += z_; }
        const int pn = u.pn, row0 = u.pm * 256 + wr * 64 + fr, cin = wc * 32 + 8 * fq;
        if (pn >= 104) {
            float* S = (float*)(ws + WS_SMALL);
#pragma unroll
            for (int ai = 0; ai < 2; ++ai)
#pragma unroll
                for (int m = 0; m < 4; ++m) { float* rowp = S + (size_t)(row0 + ai * 128 + m * 16) * 128 + cin;
                    *(f32x4*)(rowp) = acc[ai][0][m][0]; *(f32x4*)(rowp + 4) = acc[ai][0][m][1]; }
            return;
        }
        bf16_t* base; int ldc, colt; bf16_t* halo = nullptr; bool gate = false;
        if (pn < 16) { base = (bf16_t*)(ws + WS_ZSSM); ldc = 4096; colt = pn * 256; }
        else if (pn < 40) { base = (bf16_t*)(ws + WS_XBC); ldc = 6144; colt = (pn - 16) * 256; halo = (bf16_t*)(ws + WS_HALO_XBC); }
        else if (pn < 72) { base = (bf16_t*)(ws + WS_QKV); ldc = 8192; colt = (pn - 40) * 256; halo = (bf16_t*)(ws + WS_HALO_QKV); }
        else if (pn < 88) { base = (bf16_t*)(ws + WS_ZGDN); ldc = 4096; colt = (pn - 72) * 256; }
        else { base = (bf16_t*)(ws + WS_GATES); ldc = 4096; colt = (pn - 88) * 256; gate = true; }
        const int col0 = colt + cin;
        f32x4 bv[2][2];
#pragma unroll
        for (int bj = 0; bj < 2; ++bj)
#pragma unroll
            for (int n = 0; n < 2; ++n) bv[bj][n] = gate ? *(const f32x4*)(gate_b + col0 + bj * 128 + 4 * n) : (f32x4){0.f, 0.f, 0.f, 0.f};
#pragma unroll
        for (int ai = 0; ai < 2; ++ai)
#pragma unroll
            for (int m = 0; m < 4; ++m) { const int r = row0 + ai * 128 + m * 16; bf16_t* rowp = base + (size_t)r * ldc + col0;
#pragma unroll
                for (int bj = 0; bj < 2; ++bj) { f32x4 v0 = acc[ai][bj][m][0] + bv[bj][0], v1 = acc[ai][bj][m][1] + bv[bj][1];
                    if (gate) {
#pragma unroll
                        for (int e = 0; e < 4; ++e) { v0[e] = sigmoidf_(v0[e]); v1[e] = sigmoidf_(v1[e]); } }
                    u32x4 w; w.x = cvt_pk_bf16(v0[0], v0[1]); w.y = cvt_pk_bf16(v0[2], v0[3]); w.z = cvt_pk_bf16(v1[0], v1[1]); w.w = cvt_pk_bf16(v1[2], v1[3]);
                    *(u32x4*)(rowp + bj * 128) = w;
                    if (halo != nullptr && m == 3 && fr >= 13) {
                        const int gc = hh * 128 + (r >> 6);
                        *(u32x4*)(halo + (size_t)(gc * 3 + (fr - 13)) * ldc + col0 + bj * 128) = w; }
                } }
    }
};
struct EpiSmall {
    static constexpr bool PERM = true, AFTER_DRAIN = false; static constexpr bool TWO_PASS = false;
    float* S;
    __device__ __forceinline__ void operator()(const f32x4 (&acc)[2][2][4][2], const Unit& u, int wr, int wc, int fr, int fq) const {
        { int z_ = 0; asm volatile("" : "+v"(z_)); fr += z_; }
        const int row0 = u.pm * 256 + wr * 64 + fr, cin = wc * 32 + 8 * fq;
#pragma unroll
        for (int ai = 0; ai < 2; ++ai)
#pragma unroll
            for (int m = 0; m < 4; ++m) { float* rowp = S + (size_t)(row0 + ai * 128 + m * 16) * 128 + cin;
                *(f32x4*)(rowp) = acc[ai][0][m][0]; *(f32x4*)(rowp + 4) = acc[ai][0][m][1]; }
    }
};
template <int WHICH> struct EpiMix {
    static constexpr bool PERM = true, AFTER_DRAIN = false; static constexpr bool TWO_PASS = false;
    unsigned char* ws;
    __device__ __forceinline__ void operator()(const f32x4 (&acc)[2][2][4][2], const Unit& u, int wr, int wc, int fr, int fq) const {
        { int z_ = 0; asm volatile("" : "+v"(z_)); fr += z_; }
        const int row0 = u.pm * 256 + wr * 64 + fr, col0 = u.pn * 256 + wc * 32 + 8 * fq;
        const bf16_t* G = (const bf16_t*)(ws + WS_GATES) + WHICH * 2048; bf16_t* Mx = (bf16_t*)(ws + WS_MIXED);
#pragma unroll
        for (int ai = 0; ai < 2; ++ai)
#pragma unroll
            for (int m = 0; m < 4; ++m) { const int r = row0 + ai * 128 + m * 16;
#pragma unroll
                for (int bj = 0; bj < 2; ++bj) {
                    const u32x4 g = *(const u32x4*)(G + (size_t)r * 4096 + col0 + bj * 128);
                    f32x4 v0 = acc[ai][bj][m][0], v1 = acc[ai][bj][m][1];
                    v0[0] *= bflo(g.x); v0[1] *= bfhi(g.x); v0[2] *= bflo(g.y); v0[3] *= bfhi(g.y);
                    v1[0] *= bflo(g.z); v1[1] *= bfhi(g.z); v1[2] *= bflo(g.w); v1[3] *= bfhi(g.w);
                    u32x4* dst = (u32x4*)(Mx + (size_t)r * 2048 + col0 + bj * 128);
                    if (WHICH == 1) { const u32x4 p = *dst;
                        v0[0] += bflo(p.x); v0[1] += bfhi(p.x); v0[2] += bflo(p.y); v0[3] += bfhi(p.y);
                        v1[0] += bflo(p.z); v1[1] += bfhi(p.z); v1[2] += bflo(p.w); v1[3] += bfhi(p.w); }
                    u32x4 w; w.x = cvt_pk_bf16(v0[0], v0[1]); w.y = cvt_pk_bf16(v0[2], v0[3]); w.z = cvt_pk_bf16(v1[0], v1[1]); w.w = cvt_pk_bf16(v1[2], v1[3]);
                    *dst = w; }
                asm volatile("" ::: "memory"); }
    }
};
struct EpiMixF {
    static constexpr bool PERM = true, AFTER_DRAIN = false; static constexpr bool TWO_PASS = true;
    unsigned char* ws;
    __device__ __forceinline__ void mid(f32x4 (&acc)[2][2][4][2], const Unit& u, int wr, int wc, int fr, int fq) const {
        { int z_ = 0; asm volatile("" : "+v"(z_)); fr += z_; }
        const int row0 = u.pm * 256 + wr * 64 + fr, col0 = u.pn * 256 + wc * 32 + 8 * fq;
        const bf16_t* G = (const bf16_t*)(ws + WS_GATES);
#pragma unroll
        for (int ai = 0; ai < 2; ++ai)
#pragma unroll
            for (int m = 0; m < 4; ++m) { const int r = row0 + ai * 128 + m * 16;
#pragma unroll
                for (int bj = 0; bj < 2; ++bj) {
                    const u32x4 gs = *(const u32x4*)(G + (size_t)r * 4096 + col0 + bj * 128), gg = *(const u32x4*)(G + (size_t)r * 4096 + 2048 + col0 + bj * 128);
                    float s_[8], g_[8]; unpack8(gs, s_); unpack8(gg, g_);
#pragma unroll
                    for (int e = 0; e < 4; ++e) { acc[ai][bj][m][0][e] *= s_[e] * __builtin_amdgcn_rcpf(fmaxf(g_[e], 1e-30f)); acc[ai][bj][m][1][e] *= s_[4 + e] * __builtin_amdgcn_rcpf(fmaxf(g_[4 + e], 1e-30f)); } }
                asm volatile("" ::: "memory"); }
    }
    __device__ __forceinline__ void operator()(const f32x4 (&acc)[2][2][4][2], const Unit& u, int wr, int wc, int fr, int fq) const {
        { int z_ = 0; asm volatile("" : "+v"(z_)); fr += z_; }
        const int row0 = u.pm * 256 + wr * 64 + fr, col0 = u.pn * 256 + wc * 32 + 8 * fq;
        const bf16_t* G = (const bf16_t*)(ws + WS_GATES) + 2048; bf16_t* Mx = (bf16_t*)(ws + WS_MIXED);
#pragma unroll
        for (int ai = 0; ai < 2; ++ai)
#pragma unroll
            for (int m = 0; m < 4; ++m) { const int r = row0 + ai * 128 + m * 16;
#pragma unroll
                for (int bj = 0; bj < 2; ++bj) {
                    const u32x4 gg = *(const u32x4*)(G + (size_t)r * 4096 + col0 + bj * 128); float g_[8]; unpack8(gg, g_);
                    f32x4 v0 = acc[ai][bj][m][0], v1 = acc[ai][bj][m][1];
#pragma unroll
                    for (int e = 0; e < 4; ++e) { v0[e] *= fmaxf(g_[e], 1e-30f); v1[e] *= fmaxf(g_[4 + e], 1e-30f); }
                    *(u32x4*)(Mx + (size_t)r * 2048 + col0 + bj * 128) = (u32x4){pkc(v0[0], v0[1]), pkc(v0[2], v0[3]), pkc(v1[0], v1[1]), pkc(v1[2], v1[3])}; }
                asm volatile("" ::: "memory"); }
    }
};
struct EpiOut {
    static constexpr bool PERM = true, AFTER_DRAIN = false; static constexpr bool TWO_PASS = false;
    const float* x; bf16_t* hb; float* ssq;
    __device__ __forceinline__ void operator()(const f32x4 (&acc)[2][2][4][2], const Unit& u, int wr, int wc, int fr, int fq) const {
        { int z_ = 0; asm volatile("" : "+v"(z_)); fr += z_; }
        const int row0 = u.pm * 256 + wr * 64 + fr, col0 = u.pn * 256 + wc * 32 + 8 * fq;
#pragma unroll
        for (int ai = 0; ai < 2; ++ai)
#pragma unroll
            for (int m = 0; m < 4; ++m) { const int r = row0 + ai * 128 + m * 16; const size_t off = (size_t)r * 2048 + col0; float ss = 0.f;
#pragma unroll
                for (int bj = 0; bj < 2; ++bj) { const f32x4 v0 = *(const f32x4*)(x + off + bj * 128) + acc[ai][bj][m][0], v1 = *(const f32x4*)(x + off + bj * 128 + 4) + acc[ai][bj][m][1];
                    ss += (v0[0] * v0[0] + v0[1] * v0[1]) + (v0[2] * v0[2] + v0[3] * v0[3]) + (v1[0] * v1[0] + v1[1] * v1[1]) + (v1[2] * v1[2] + v1[3] * v1[3]);
                    *(u32x4*)(hb + off + bj * 128) = (u32x4){pkc(v0[0], v0[1]), pkc(v0[2], v0[3]), pkc(v1[0], v1[1]), pkc(v1[2], v1[3])}; }
                ss += __shfl_xor(ss, 16); ss += __shfl_xor(ss, 32);
                if (fq == 0) ssq[(size_t)r * 32 + u.pn * 4 + wc] = ss;
                asm volatile("" ::: "memory"); }
    }
};
struct EpiQ {
    static constexpr bool PERM = true, AFTER_DRAIN = false; static constexpr bool TWO_PASS = false;
    bf16_t* O;
    __device__ __forceinline__ void operator()(const f32x4 (&acc)[2][2][4][2], const Unit& u, int wr, int wc, int fr, int fq) const {
        { int z_ = 0; asm volatile("" : "+v"(z_)); fr += z_; }
        const int row0 = u.pm * 256 + wr * 64 + fr, col0 = u.pn * 256 + wc * 32 + 8 * fq;
#pragma unroll
        for (int ai = 0; ai < 2; ++ai)
#pragma unroll
            for (int m = 0; m < 4; ++m) { bf16_t* rowp = O + (size_t)(row0 + ai * 128 + m * 16) * 2048 + col0;
#pragma unroll
                for (int bj = 0; bj < 2; ++bj) { const f32x4 v0 = acc[ai][bj][m][0], v1 = acc[ai][bj][m][1];
                    u32x4 w; w.x = pkc(v0[0], v0[1]); w.y = pkc(v0[2], v0[3]); w.z = pkc(v1[0], v1[1]); w.w = pkc(v1[2], v1[3]);
                    *(u32x4*)(rowp + bj * 128) = w; } }
    }
};

constexpr int TB = 32;
__device__ __forceinline__ float raw_at(const bf16_t* buf, const bf16_t* halo, int ld, int hh, int tl, int col) {
    if (tl >= 0) return bf2f(buf[(size_t)tl * ld + col]);
    if (hh == 0) return 0.f;
    return bf2f(halo[(size_t)((hh * 128 - 1) * 3 + (tl + 3)) * ld + col]);
}
__device__ __forceinline__ void ssd_naive(const Ctx& C, int hh, int g) {
    bf16_t* XBC = (bf16_t*)(C.ws + WS_XBC); const bf16_t* HALO = (const bf16_t*)(C.ws + WS_HALO_XBC);
    const float* SM = (const float*)(C.ws + WS_SMALLF) + (size_t)hh * TH * 128;
    LAS float* Bs = (LAS float*)C.lds; LAS float* Cs = Bs + TB * 128; LAS float* Xs = Cs + TB * 128; LAS float* dts = Xs + TB * 512; LAS float* dAs = dts + TB * 8;
    const int tid = C.tid, r = C.wave, p = C.lane, head = g * 8 + r, xcol = head * 64 + p;
    const int bccol = (tid < 128) ? (4096 + g * 128 + tid) : (5120 + g * 128 + ((tid - 128) & 127));
    const float* cw = C.in(I_SCW); const float* cb = C.in(I_SCB);
    const float xw0 = cw[xcol], xw1 = cw[6144 + xcol], xw2 = cw[2 * 6144 + xcol], xw3 = cw[3 * 6144 + xcol], xb = cb[xcol];
    const float bw0 = cw[bccol], bw1 = cw[6144 + bccol], bw2 = cw[2 * 6144 + bccol], bw3 = cw[3 * 6144 + bccol], bb = cb[bccol];
    float x0 = raw_at(XBC, HALO, 6144, hh, -3, xcol), x1 = raw_at(XBC, HALO, 6144, hh, -2, xcol), x2 = raw_at(XBC, HALO, 6144, hh, -1, xcol);
    float b0 = raw_at(XBC, HALO, 6144, hh, -3, bccol), b1 = raw_at(XBC, HALO, 6144, hh, -2, bccol), b2 = raw_at(XBC, HALO, 6144, hh, -1, bccol);
    const float Dh = C.in(I_SD)[head];
    float* stp = (float*)(C.ws + WS_ST_SSD) + (size_t)(head * 64 + p) * 128;
    f32x4 h[32];
#pragma unroll
    for (int j = 0; j < 32; ++j) h[j] = *(const f32x4*)(stp + 4 * j);
    for (int t0 = 0; t0 < TH; t0 += TB) {
#pragma unroll 4
        for (int s = 0; s < TB; ++s) {
            const float rb = bf2f(XBC[(size_t)(t0 + s) * 6144 + bccol]);
            const float vb = siluf_(bw0 * b0 + bw1 * b1 + bw2 * b2 + bw3 * rb + bb); b0 = b1; b1 = b2; b2 = rb;
            if (tid < 128) Bs[s * 128 + tid] = vb; else if (tid < 256) Cs[s * 128 + (tid - 128)] = vb;
            const float rx = bf2f(XBC[(size_t)(t0 + s) * 6144 + xcol]);
            const float vx = siluf_(xw0 * x0 + xw1 * x1 + xw2 * x2 + xw3 * rx + xb); x0 = x1; x1 = x2; x2 = rx;
            Xs[s * 512 + tid] = vx;
        }
        if (tid < TB * 8) { const int s = tid >> 3, rr = tid & 7, hd = g * 8 + rr;
            const float dtv = softplusf_(SM[(size_t)(t0 + s) * 128 + hd] + C.in(I_SDTB)[hd]);
            dts[s * 8 + rr] = dtv; dAs[s * 8 + rr] = __expf(-__expf(C.in(I_SALOG)[hd]) * dtv); }
        __syncthreads();
#pragma unroll 1
        for (int s = 0; s < TB; ++s) {
            const float xv = Xs[s * 512 + tid], dt = dts[s * 8 + r], dA = dAs[s * 8 + r], xdt = xv * dt;
            float y = 0.f;
#pragma unroll
            for (int j = 0; j < 32; ++j) { const f32x4 bq = *(const LAS f32x4*)(Bs + s * 128 + 4 * j), cq = *(const LAS f32x4*)(Cs + s * 128 + 4 * j);
                h[j] = h[j] * dA + xdt * bq; y += (h[j].x * cq.x + h[j].y * cq.y) + (h[j].z * cq.z + h[j].w * cq.w);
                if ((j & 3) == 3) asm volatile("" ::: "memory"); }
            XBC[(size_t)(t0 + s) * 6144 + xcol] = (bf16_t)f2bf(y + xv * Dh);
        }
        __syncthreads();
    }
#pragma unroll
    for (int j = 0; j < 32; ++j) *(f32x4*)(stp + 4 * j) = h[j];
}
__device__ __forceinline__ void gdn_naive(const Ctx& C, int hh, int head) {
    bf16_t* QKV = (bf16_t*)(C.ws + WS_QKV); const bf16_t* HALO = (const bf16_t*)(C.ws + WS_HALO_QKV);
    const float* SM = (const float*)(C.ws + WS_SMALLF) + (size_t)hh * TH * 128;
    LAS float* qs = (LAS float*)C.lds; LAS float* ks = qs + TB * 128; LAS float* vs = ks + TB * 128; LAS float* bts = vs + TB * 256; LAS float* gs = bts + TB;
    const int tid = C.tid, lane = C.lane, wave = C.wave;
    const int ccol = (tid < 128) ? (head * 128 + tid) : (tid < 256 ? (2048 + head * 128 + (tid - 128)) : (4096 + head * 256 + (tid - 256)));
    const float* cw = C.in(I_GCW);
    const float w0 = cw[ccol], w1 = cw[8192 + ccol], w2 = cw[2 * 8192 + ccol], w3 = cw[3 * 8192 + ccol];
    float r0 = raw_at(QKV, HALO, 8192, hh, -3, ccol), r1 = raw_at(QKV, HALO, 8192, hh, -2, ccol), r2 = raw_at(QKV, HALO, 8192, hh, -1, ccol);
    const float aneg = -__expf(C.in(I_GALOG)[head]), dtb = C.in(I_GDTB)[head];
    const int c = tid & 255;
    float* stp = (float*)(C.ws + WS_ST_GDN) + (size_t)(head * 256 + c) * 128;
    f32x4 S[32];
    if (tid < 256) {
#pragma unroll
        for (int j = 0; j < 32; ++j) S[j] = *(const f32x4*)(stp + 4 * j);
    }
    for (int t0 = 0; t0 < TH; t0 += TB) {
#pragma unroll 4
        for (int s = 0; s < TB; ++s) {
            const float rw = bf2f(QKV[(size_t)(t0 + s) * 8192 + ccol]);
            const float v = siluf_(w0 * r0 + w1 * r1 + w2 * r2 + w3 * rw); r0 = r1; r1 = r2; r2 = rw;
            if (tid < 128) qs[s * 128 + tid] = v; else if (tid < 256) ks[s * 128 + (tid - 128)] = v; else vs[s * 256 + (tid - 256)] = v;
        }
        if (tid < TB) { bts[tid] = sigmoidf_(SM[(size_t)(t0 + tid) * 128 + 64 + head]);
            gs[tid] = __expf(aneg * softplusf_(SM[(size_t)(t0 + tid) * 128 + 80 + head] + dtb)); }
        __syncthreads();
        for (int row = wave; row < 2 * TB; row += 8) { LAS float* rp = (row < TB) ? (qs + row * 128) : (ks + (row - TB) * 128);
            const float a = rp[lane], b = rp[lane + 64]; const float ss = wave_sum(a * a + b * b);
            const float sc = rsqrtf(ss + EPS) * ((row < TB) ? 0.08838834764831845f : 1.0f);
            rp[lane] = a * sc; rp[lane + 64] = b * sc; }
        __syncthreads();
        if (tid < 256) {
#pragma unroll 1
            for (int s = 0; s < TB; ++s) {
                const float a = gs[s], bt = bts[s], v = vs[s * 256 + c];
                float dot = 0.f;
#pragma unroll
                for (int j = 0; j < 32; ++j) { const f32x4 kq = *(const LAS f32x4*)(ks + s * 128 + 4 * j); dot += (S[j].x * kq.x + S[j].y * kq.y) + (S[j].z * kq.z + S[j].w * kq.w);
                    if ((j & 3) == 3) asm volatile("" ::: "memory"); }
                const float vn = bt * (v - a * dot);
                float o = 0.f;
#pragma unroll
                for (int j = 0; j < 32; ++j) { const f32x4 kq = *(const LAS f32x4*)(ks + s * 128 + 4 * j), qq = *(const LAS f32x4*)(qs + s * 128 + 4 * j);
                    S[j] = S[j] * a + kq * vn; o += (S[j].x * qq.x + S[j].y * qq.y) + (S[j].z * qq.z + S[j].w * qq.w);
                    if ((j & 3) == 3) asm volatile("" ::: "memory"); }
                QKV[(size_t)(t0 + s) * 8192 + 4096 + head * 256 + c] = (bf16_t)f2bf(o);
            }
        }
        __syncthreads();
    }
    if (tid < 256) {
#pragma unroll
        for (int j = 0; j < 32; ++j) *(f32x4*)(stp + 4 * j) = S[j];
    }
}


__device__ __forceinline__ u32x4 raw8_at(const bf16_t* buf, const bf16_t* halo, int ld, int hh, int lr, int col) {
    if (lr >= 0) return *(const u32x4*)(buf + (size_t)lr * ld + col);
    if (hh == 0) return (u32x4){0u, 0u, 0u, 0u};
    return *(const u32x4*)(halo + (size_t)((hh * 128 - 1) * 3 + (lr + 3)) * ld + col);
}
__device__ __forceinline__ void p2_bc_conv(const Ctx& C, int hh) {
    const bf16_t* XBC = (const bf16_t*)(C.ws + WS_XBC); const bf16_t* HALO = (const bf16_t*)(C.ws + WS_HALO_XBC); bf16_t* BC = (bf16_t*)(C.ws + WS_BCCONV);
    const float* cw = C.in(I_SCW); const float* cb = C.in(I_SCB);
    const int gt = C.bid * NTHREADS + C.tid, NGT = C.G * NTHREADS;
    for (int it = gt; it < (TH / 8) * 256; it += NGT) {
        const int cgp = it & 255, r0 = (it >> 8) * 8, col = 4096 + cgp * 8;
        float w[4][8], b[8];
#pragma unroll
        for (int k = 0; k < 4; ++k) { const f32x4 a = *(const f32x4*)(cw + k * 6144 + col), c2 = *(const f32x4*)(cw + k * 6144 + col + 4);
            w[k][0] = a.x; w[k][1] = a.y; w[k][2] = a.z; w[k][3] = a.w; w[k][4] = c2.x; w[k][5] = c2.y; w[k][6] = c2.z; w[k][7] = c2.w; }
        { const f32x4 a = *(const f32x4*)(cb + col), c2 = *(const f32x4*)(cb + col + 4); b[0] = a.x; b[1] = a.y; b[2] = a.z; b[3] = a.w; b[4] = c2.x; b[5] = c2.y; b[6] = c2.z; b[7] = c2.w; }
        u32x4 raw[11];
#pragma unroll
        for (int j = 0; j < 11; ++j) raw[j] = raw8_at(XBC, HALO, 6144, hh, r0 - 3 + j, col);
        float x0[8], x1[8], x2[8], x3[8];
        unpack8(raw[0], x0); unpack8(raw[1], x1); unpack8(raw[2], x2);
#pragma unroll
        for (int r = 0; r < 8; ++r) { unpack8(raw[3 + r], x3); float o[8];
#pragma unroll
            for (int e = 0; e < 8; ++e) { o[e] = siluf_(w[0][e] * x0[e] + w[1][e] * x1[e] + w[2][e] * x2[e] + w[3][e] * x3[e] + b[e]); x0[e] = x1[e]; x1[e] = x2[e]; x2[e] = x3[e]; }
            u32x4 ov; ov.x = pkc(o[0], o[1]); ov.y = pkc(o[2], o[3]); ov.z = pkc(o[4], o[5]); ov.w = pkc(o[6], o[7]);
            *(u32x4*)(BC + (size_t)(r0 + r) * 2048 + cgp * 8) = ov; }
    }
}

constexpr int SP = 136;
constexpr int SSD_CS = 0, SSD_BS = 128 * SP * 2, SSD_XT = 2 * 128 * SP * 2, SSD_XW = SSD_XT + 64 * SP * 2, SSD_HS = SSD_XW + 64 * SP * 2, SSD_F = SSD_HS + 2 * 64 * SP * 2;
static_assert(SSD_F + 3072 + 1280 <= LDS_CTL_OFF, "SSD LDS map");
#define MFMA16(F, S, A) __builtin_amdgcn_mfma_f32_16x16x32_bf16((F), (S), (A), 0, 0, 0)
typedef short s16x4 __attribute__((ext_vector_type(4)));
__device__ __forceinline__ bf16x8 cat44(const u32x2 a, const u32x2 b) { const u32x4 v = (u32x4){a.x, a.y, b.x, b.y}; return __builtin_bit_cast(bf16x8, v); }
__device__ __forceinline__ void ssd_chunked(const Ctx& C, int hh, int unit) {
    const int head = unit >> 1, ph = unit & 1;
    bf16_t* XBC = (bf16_t*)(C.ws + WS_XBC); const bf16_t* HALO = (const bf16_t*)(C.ws + WS_HALO_XBC); const bf16_t* BC = (const bf16_t*)(C.ws + WS_BCCONV);
    const float* SM = (const float*)(C.ws + WS_SMALLF) + (size_t)hh * TH * 128;
    LAS bf16_t* Cs = (LAS bf16_t*)(C.lds + SSD_CS); LAS bf16_t* Bs = (LAS bf16_t*)(C.lds + SSD_BS); LAS bf16_t* XsT = (LAS bf16_t*)(C.lds + SSD_XT);
    LAS bf16_t* XwT = (LAS bf16_t*)(C.lds + SSD_XW); LAS bf16_t* Hs = (LAS bf16_t*)(C.lds + SSD_HS);
    LAS float* avec = (LAS float*)(C.lds + SSD_F);
    LAS float* cwt = avec + 768;
    const int tid = C.tid, lane = C.lane, w = C.wave, i = lane & 15, g = lane >> 4, grp = head >> 3;
    const float aneg = -__expf(C.in(I_SALOG)[head]), dtb = C.in(I_SDTB)[head], Dh = C.in(I_SD)[head];
    const int cg = tid & 15, sr = tid >> 4, xcol = head * 64 + 32 * ph + cg * 2;
    if (tid < 160) { const int k = tid >> 5, c = tid & 31; cwt[tid] = (k < 4) ? C.in(I_SCW)[k * 6144 + head * 64 + 32 * ph + c] : C.in(I_SCB)[head * 64 + 32 * ph + c]; }
    float* stp = (float*)(C.ws + WS_ST_SSD) + (size_t)(head * 64 + 32 * ph) * 128;
    f32x4 hacc[2];
#pragma unroll
    for (int pt = 0; pt < 2; ++pt)
#pragma unroll
        for (int e = 0; e < 4; ++e) { const float v = stp[(16 * pt + 4 * g + e) * 128 + 16 * w + i]; hacc[pt][e] = v; Hs[(16 * pt + 4 * g + e) * SP + 16 * w + i] = (bf16_t)f2bf(v); }
    u32x4 pbc[4], pcf[4]; unsigned px[7]; float pdt0 = 0.f, pdt1 = 0.f;
#define SSD_PREFETCH(t0_) do { \
        _Pragma("unroll") for (int k = 0; k < 4; ++k) { const int q = tid + 512 * k, row = q >> 4, pc = q & 15; \
            pbc[k] = *(const u32x4*)(BC + (size_t)((t0_) + row) * 2048 + grp * 128 + pc * 8); } \
        { const int lt_ = (w < 4) ? w : 11 - w, l_ = 16 * lt_ + (lane & 15), g_ = lane >> 4; \
          _Pragma("unroll") for (int ks = 0; ks < 4; ++ks) pcf[ks] = *(const u32x4*)(BC + (size_t)((t0_) + l_) * 2048 + 1024 + grp * 128 + 32 * ks + 8 * g_); } \
        { const int gc = hh * 128 + (t0_) / 64 - 1, gcs_ = gc < 0 ? 0 : gc; \
          _Pragma("unroll") for (int j = 0; j < 7; ++j) { const int lr = 4 * sr - 3 + j; \
            const bf16_t* pp = (j >= 3 || lr >= 0) ? (XBC + (size_t)((t0_) + (lr < 0 ? 0 : lr)) * 6144 + xcol) : (HALO + (size_t)(gcs_ * 3 + lr + 3) * 6144 + xcol); \
            px[j] = *(const unsigned*)pp; if (j < 3 && lr < 0 && gc < 0) px[j] = 0u; } } } while (0)
#define SSD_DTLOAD(t0_) do { if (tid < 64) { pdt0 = SM[(size_t)((t0_) + 2 * tid) * 128 + head]; pdt1 = SM[(size_t)((t0_) + 2 * tid + 1) * 128 + head]; } } while (0)
#define SSD_DTSCAN(b_) do { if (tid < 64) { const float d0 = softplusf_(pdt0 + dtb), d1 = softplusf_(pdt1 + dtb); const float a0 = d0 * aneg, a1 = d1 * aneg; \
            float s = a0 + a1; \
            _Pragma("unroll") for (int o = 1; o < 64; o <<= 1) { const float t = __shfl_up(s, o); if (lane >= o) s += t; } \
            const float aend_ = __shfl(s, lane | 15); \
            LAS float* av_ = avec + (b_) * 384; av_[128 + 2 * lane] = d0; av_[128 + 2 * lane + 1] = d1; av_[2 * lane] = s - a1; av_[2 * lane + 1] = s; \
            av_[256 + 2 * lane] = d0 * __expf(aend_ - (s - a1)); av_[256 + 2 * lane + 1] = d1 * __expf(aend_ - s); } } while (0)
    SSD_PREFETCH(0); SSD_DTLOAD(0); SSD_DTSCAN(0);
    if (128 < TH) SSD_DTLOAD(128);
    __syncthreads();
    const int tid0 = tid, lane0 = lane;
    for (int t0 = 0; t0 < TH; t0 += 128) {
        int tid = tid0, lane = lane0; asm volatile("" : "+v"(tid), "+v"(lane));
        const int i = lane & 15, g = lane >> 4, cg = tid & 15, sr = tid >> 4;
        const LAS float* acs = avec + ((t0 >> 7) & 1) * 384; const LAS float* dts = acs + 128; const LAS float* esv = acs + 256;
        const LAS bf16_t* HsR = Hs + ((t0 >> 7) & 1) * (64 * SP); LAS bf16_t* HsW = Hs + (((t0 >> 7) + 1) & 1) * (64 * SP);
#pragma unroll
        for (int k = 0; k < 4; ++k) { const int q = tid + 512 * k, row = q >> 4, pc = q & 15;
            *(LAS u32x4*)(Bs + row * SP + pc * 8) = pbc[k]; }
        { const float alast = acs[127]; const int rw = 4 * sr; float sc[4];
#pragma unroll
          for (int r = 0; r < 4; ++r) sc[r] = dts[rw + r] * __expf(alast - acs[rw + r]);
#pragma unroll
          for (int e = 0; e < 2; ++e) { const int c = cg * 2 + e; const float k0 = cwt[c], k1 = cwt[32 + c], k2 = cwt[64 + c], k3 = cwt[96 + c], kb = cwt[128 + c];
              float v[4];
#pragma unroll
              for (int r = 0; r < 4; ++r) { const float a0 = e ? bfhi(px[r]) : bflo(px[r]), a1 = e ? bfhi(px[r + 1]) : bflo(px[r + 1]), a2 = e ? bfhi(px[r + 2]) : bflo(px[r + 2]), a3 = e ? bfhi(px[r + 3]) : bflo(px[r + 3]);
                  v[r] = siluf_(k0 * a0 + k1 * a1 + k2 * a2 + k3 * a3 + kb); }
              *(LAS u32x2*)(XsT + c * SP + rw) = (u32x2){pkc(v[0], v[1]), pkc(v[2], v[3])};
              *(LAS u32x2*)(XwT + c * SP + rw) = (u32x2){pkc(v[0] * sc[0], v[1] * sc[1]), pkc(v[2] * sc[2], v[3] * sc[3])}; } }
        __syncthreads();
        {
            const int lt = (w < 4) ? w : 11 - w;
            const int l = 16 * lt + i; const float acl = acs[l];
            bf16x8 cf[4], hq[8];
#pragma unroll
            for (int ks = 0; ks < 4; ++ks) cf[ks] = __builtin_bit_cast(bf16x8, pcf[ks]);
            if (t0 + 128 < TH) SSD_PREFETCH(t0 + 128);
            f32x4 yd[2];
#pragma unroll
            for (int pt = 0; pt < 2; ++pt) yd[pt] = (f32x4){0.f, 0.f, 0.f, 0.f};
#pragma unroll
            for (int ks = 0; ks < 4; ++ks)
#pragma unroll
                for (int pt = 0; pt < 2; ++pt) hq[ks * 2 + pt] = *(const LAS bf16x8*)(HsR + (16 * pt + i) * SP + 32 * ks + 8 * g);
#pragma unroll
            for (int ks = 0; ks < 4; ++ks)
#pragma unroll
                for (int pt = 0; pt < 2; ++pt) yd[pt] = MFMA16(hq[ks * 2 + pt], cf[ks], yd[pt]);
            { const float el = __expf(acl);
#pragma unroll
              for (int pt = 0; pt < 2; ++pt) yd[pt] = yd[pt] * el; }
#pragma unroll
            for (int j2 = 0; j2 < 4; ++j2) {
                if (2 * j2 + 1 < lt) {
                    bf16x8 bq[8], xq[2];
#pragma unroll
                    for (int ks = 0; ks < 4; ++ks) { bq[ks] = *(const LAS bf16x8*)(Bs + (32 * j2 + i) * SP + 32 * ks + 8 * g); bq[4 + ks] = *(const LAS bf16x8*)(Bs + (32 * j2 + 16 + i) * SP + 32 * ks + 8 * g); }
#pragma unroll
                    for (int pt = 0; pt < 2; ++pt) xq[pt] = cat44(*(const LAS u32x2*)(XsT + (16 * pt + i) * SP + 32 * j2 + 4 * g), *(const LAS u32x2*)(XsT + (16 * pt + i) * SP + 32 * j2 + 16 + 4 * g));
                    const f32x4 e0 = *(const LAS f32x4*)(esv + 32 * j2 + 4 * g), e1 = *(const LAS f32x4*)(esv + 32 * j2 + 16 + 4 * g);
                    const float el = __expf(acl - acs[32 * j2 + 31]);
                    f32x4 d0 = (f32x4){0.f, 0.f, 0.f, 0.f}, d1 = (f32x4){0.f, 0.f, 0.f, 0.f};
#pragma unroll
                    for (int ks = 0; ks < 4; ++ks) { d0 = MFMA16(bq[ks], cf[ks], d0); d1 = MFMA16(bq[4 + ks], cf[ks], d1); }
                    const f32x4 v0 = d0 * (e0 * el), v1 = d1 * (e1 * el);
                    const u32x4 sfu = (u32x4){pkc(v0[0], v0[1]), pkc(v0[2], v0[3]), pkc(v1[0], v1[1]), pkc(v1[2], v1[3])};
                    const bf16x8 sf = __builtin_bit_cast(bf16x8, sfu);
#pragma unroll
                    for (int pt = 0; pt < 2; ++pt) yd[pt] = MFMA16(xq[pt], sf, yd[pt]);
                } else if (2 * j2 <= lt) {
                    const bool two = (2 * j2 + 1 <= lt);
                    bf16x8 bq[8], xq[2];
#pragma unroll
                    for (int ks = 0; ks < 4; ++ks) { bq[ks] = *(const LAS bf16x8*)(Bs + (32 * j2 + i) * SP + 32 * ks + 8 * g); bq[4 + ks] = *(const LAS bf16x8*)(Bs + (32 * j2 + 16 + i) * SP + 32 * ks + 8 * g); }
#pragma unroll
                    for (int pt = 0; pt < 2; ++pt) xq[pt] = cat44(*(const LAS u32x2*)(XsT + (16 * pt + i) * SP + 32 * j2 + 4 * g), *(const LAS u32x2*)(XsT + (16 * pt + i) * SP + 32 * j2 + 16 + 4 * g));
                    const f32x4 a0 = *(const LAS f32x4*)(acs + 32 * j2 + 4 * g), a1 = *(const LAS f32x4*)(acs + 32 * j2 + 16 + 4 * g);
                    const f32x4 q0 = *(const LAS f32x4*)(dts + 32 * j2 + 4 * g), q1 = *(const LAS f32x4*)(dts + 32 * j2 + 16 + 4 * g);
                    f32x4 d0 = (f32x4){0.f, 0.f, 0.f, 0.f}, d1 = (f32x4){0.f, 0.f, 0.f, 0.f};
#pragma unroll
                    for (int ks = 0; ks < 4; ++ks) { d0 = MFMA16(bq[ks], cf[ks], d0); if (two) d1 = MFMA16(bq[4 + ks], cf[ks], d1); }
                    float v0[4], v1[4];
#pragma unroll
                    for (int e = 0; e < 4; ++e) { const int s = 32 * j2 + 4 * g + e;
                        v0[e] = (s <= l) ? d0[e] * __expf(fminf(acl - a0[e], 0.f)) * q0[e] : 0.f;
                        v1[e] = (two && s + 16 <= l) ? d1[e] * __expf(fminf(acl - a1[e], 0.f)) * q1[e] : 0.f; }
                    const u32x4 sfu = (u32x4){pkc(v0[0], v0[1]), pkc(v0[2], v0[3]), pkc(v1[0], v1[1]), pkc(v1[2], v1[3])};
                    const bf16x8 sf = __builtin_bit_cast(bf16x8, sfu);
#pragma unroll
                    for (int pt = 0; pt < 2; ++pt) yd[pt] = MFMA16(xq[pt], sf, yd[pt]);
                }
            }
            if (t0 + 128 < TH) SSD_DTSCAN(((t0 >> 7) + 1) & 1);
#pragma unroll
            for (int pt = 0; pt < 2; ++pt) { float y[4];
#pragma unroll
                for (int e = 0; e < 4; ++e) { const float xv = bf2f(XsT[(16 * pt + 4 * g + e) * SP + l]); y[e] = yd[pt][e] + Dh * xv; }
                u32x2 ov; ov.x = pkc(y[0], y[1]); ov.y = pkc(y[2], y[3]);
                *(u32x2*)(XBC + (size_t)(t0 + l) * 6144 + head * 64 + 32 * ph + 16 * pt + 4 * g) = ov; }
            if (t0 + 256 < TH) SSD_DTLOAD(t0 + 256);
        }
        {
            const float ec = __expf(acs[127]);
#pragma unroll
            for (int pt = 0; pt < 2; ++pt) hacc[pt] = hacc[pt] * ec;
            const int q = (lane & 15) >> 2, p = lane & 3;
            s16x4 ta[4], tb[4]; bf16x8 xwq[8];
#pragma unroll
            for (int ks = 0; ks < 4; ++ks) {
                ta[ks] = __builtin_amdgcn_ds_read_tr16_b64_v4i16((LAS s16x4*)(Bs + (32 * ks + 8 * g + q) * SP + 16 * w + 4 * p));
                tb[ks] = __builtin_amdgcn_ds_read_tr16_b64_v4i16((LAS s16x4*)(Bs + (32 * ks + 8 * g + 4 + q) * SP + 16 * w + 4 * p));
#pragma unroll
                for (int pt = 0; pt < 2; ++pt) xwq[ks * 2 + pt] = *(const LAS bf16x8*)(XwT + (16 * pt + i) * SP + 32 * ks + 8 * g); }
#pragma unroll
            for (int ks = 0; ks < 4; ++ks) { const bf16x8 bt = (bf16x8){ta[ks][0], ta[ks][1], ta[ks][2], ta[ks][3], tb[ks][0], tb[ks][1], tb[ks][2], tb[ks][3]};
#pragma unroll
                for (int pt = 0; pt < 2; ++pt) hacc[pt] = MFMA16(xwq[ks * 2 + pt], bt, hacc[pt]); }
#pragma unroll
            for (int pt = 0; pt < 2; ++pt)
#pragma unroll
                for (int e = 0; e < 4; ++e) HsW[(16 * pt + 4 * g + e) * SP + 16 * w + i] = (bf16_t)f2bf(hacc[pt][e]);
        }
        __syncthreads();
    }
#undef SSD_PREFETCH
#undef SSD_DTLOAD
#undef SSD_DTSCAN
    { int l2 = lane; asm volatile("" : "+v"(l2));
      float* sp2 = stp + (4 * (l2 >> 4)) * 128 + 16 * w + (l2 & 15);
#pragma unroll
      for (int pt = 0; pt < 2; ++pt)
#pragma unroll
        for (int e = 0; e < 4; ++e) sp2[(16 * pt + e) * 128] = hacc[pt][e]; }
}

constexpr int SPK = 136, SPV = 264, SPT = 72, LMP = 68;
constexpr int GP_QN = 0, GP_KN = GP_QN + 64 * SPK * 2, GP_KB = GP_KN + 64 * SPK * 2, GP_VB = GP_KB + 64 * SPK * 2, GP_TI = GP_VB + 64 * SPV * 2, GP_LM = GP_TI + 64 * SPT * 2, GP_VEC = GP_LM + 64 * LMP * 4, GP_XI = GP_VEC + 1024;
static_assert(GP_XI + 64 * LMP * 4 <= LDS_CTL_OFF, "gdn_pre LDS map");
__device__ __forceinline__ void gdn_pre(const Ctx& C, int hh) {
    bf16_t* QKV = (bf16_t*)(C.ws + WS_QKV); const bf16_t* HALO = (const bf16_t*)(C.ws + WS_HALO_QKV); const float* SM = (const float*)(C.ws + WS_SMALLF) + (size_t)hh * TH * 128;
    bf16_t* GW = (bf16_t*)(C.ws + WS_GW); bf16_t* GATT = (bf16_t*)(C.ws + WS_GATT); float* GCD = (float*)(C.ws + WS_GCD);
    LAS bf16_t* QN = (LAS bf16_t*)(C.lds + GP_QN); LAS bf16_t* KN = (LAS bf16_t*)(C.lds + GP_KN); LAS bf16_t* KB = (LAS bf16_t*)(C.lds + GP_KB); LAS bf16_t* VB = (LAS bf16_t*)(C.lds + GP_VB);
    LAS bf16_t* TI = (LAS bf16_t*)(C.lds + GP_TI); LAS float* LM = (LAS float*)(C.lds + GP_LM); LAS float* gcs = (LAS float*)(C.lds + GP_VEC); LAS float* bts = gcs + 64; LAS float* egs = bts + 64; LAS float* XI = (LAS float*)(C.lds + GP_XI);
    const float* cw = C.in(I_GCW);
    for (int item = C.bid; item < 2048; item += C.G) {
        int lane = C.lane, w = C.wave; asm volatile("" : "+v"(lane), "+s"(w));
        const int ii = lane & 15, g = lane >> 4;
        const int c = item >> 4, h = item & 15, t0 = c * 64;
        const float aneg = -__expf(C.in(I_GALOG)[h]), dtb = C.in(I_GDTB)[h];
        if (w == 0) { const float bt = sigmoidf_(SM[(size_t)(t0 + lane) * 128 + 64 + h]); float s = aneg * softplusf_(SM[(size_t)(t0 + lane) * 128 + 80 + h] + dtb);
#pragma unroll
            for (int o = 1; o < 64; o <<= 1) { const float t = __shfl_up(s, o); if (lane >= o) s += t; }
            gcs[lane] = s; bts[lane] = bt; egs[lane] = __expf(s); if (lane == 63) GCD[item] = __expf(s); }
        const int cgp = lane, sr = w;
        const int col = (cgp < 16) ? (h * 128 + cgp * 8) : (cgp < 32 ? (2048 + h * 128 + (cgp - 16) * 8) : (4096 + h * 256 + (cgp - 32) * 8));
        float o[8][8];
        { u32x4 raw[11];
#pragma unroll
          for (int j = 0; j < 11; ++j) { const int lr = 8 * sr - 3 + j;
              if (lr >= 0) raw[j] = *(const u32x4*)(QKV + (size_t)(t0 + lr) * 8192 + col);
              else { const int gc = hh * 128 + c - 1; raw[j] = gc < 0 ? (u32x4){0u, 0u, 0u, 0u} : *(const u32x4*)(HALO + (size_t)(gc * 3 + lr + 3) * 8192 + col); } }
          float wk[4][8];
#pragma unroll
          for (int k = 0; k < 4; ++k) { const f32x4 a = *(const f32x4*)(cw + k * 8192 + col), b = *(const f32x4*)(cw + k * 8192 + col + 4);
              wk[k][0] = a.x; wk[k][1] = a.y; wk[k][2] = a.z; wk[k][3] = a.w; wk[k][4] = b.x; wk[k][5] = b.y; wk[k][6] = b.z; wk[k][7] = b.w; }
          float x0[8], x1[8], x2[8], x3[8]; unpack8(raw[0], x0); unpack8(raw[1], x1); unpack8(raw[2], x2);
#pragma unroll
          for (int r = 0; r < 8; ++r) { unpack8(raw[3 + r], x3);
#pragma unroll
              for (int e = 0; e < 8; ++e) { o[r][e] = siluf_(wk[0][e] * x0[e] + wk[1][e] * x1[e] + wk[2][e] * x2[e] + wk[3][e] * x3[e]); x0[e] = x1[e]; x1[e] = x2[e]; x2[e] = x3[e]; } } }
        asm volatile("s_waitcnt vmcnt(0)" ::: "memory");
        __syncthreads();
        { const float glast = gcs[63];
#pragma unroll
          for (int r = 0; r < 8; ++r) { const int row = 8 * sr + r; float ss = 0.f;
#pragma unroll
              for (int e = 0; e < 8; ++e) ss += o[r][e] * o[r][e];
              ss += __shfl_xor(ss, 1); ss += __shfl_xor(ss, 2); ss += __shfl_xor(ss, 4); ss += __shfl_xor(ss, 8);
              const float bt = bts[row], eg = egs[row];
              float sc = (cgp < 32) ? rsqrtf(ss + EPS) : bt; if (cgp < 16) sc *= 0.08838834764831845f;
#pragma unroll
              for (int e = 0; e < 8; ++e) o[r][e] *= sc;
              const u32x4 pv = (u32x4){pkc(o[r][0], o[r][1]), pkc(o[r][2], o[r][3]), pkc(o[r][4], o[r][5]), pkc(o[r][6], o[r][7])};
              if (cgp < 16) { *(LAS u32x4*)(QN + row * SPK + cgp * 8) = pv;
                  { bf16_t* qp = QKV + (size_t)(t0 + row) * 8192 + h * 128 + 32 * (cgp >> 2) + 16 * (cgp & 1) + 4 * ((cgp >> 1) & 1);
                    *(u32x2*)qp = (u32x2){pkc(o[r][0] * eg, o[r][1] * eg), pkc(o[r][2] * eg, o[r][3] * eg)}; *(u32x2*)(qp + 8) = (u32x2){pkc(o[r][4] * eg, o[r][5] * eg), pkc(o[r][6] * eg, o[r][7] * eg)}; } }
              else if (cgp < 32) { *(LAS u32x4*)(KN + row * SPK + (cgp - 16) * 8) = pv; const float s2 = bt * eg;
                  *(LAS u32x4*)(KB + row * SPK + (cgp - 16) * 8) = (u32x4){pkc(o[r][0] * s2, o[r][1] * s2), pkc(o[r][2] * s2, o[r][3] * s2), pkc(o[r][4] * s2, o[r][5] * s2), pkc(o[r][6] * s2, o[r][7] * s2)}; }
              else *(LAS u32x4*)(VB + row * SPV + (cgp - 32) * 8) = pv; }
          if (cgp >= 16 && cgp < 32) { float kd[8];
#pragma unroll
              for (int r = 0; r < 8; ++r) kd[r] = __expf(glast - gcs[8 * sr + r]);
#pragma unroll
              for (int e = 0; e < 8; ++e) { const int dk = (cgp - 16) * 8 + e;
                  bf16_t* kp = QKV + (size_t)(t0 + (dk >> 1)) * 8192 + 2048 + h * 128 + (dk & 1) * 64 + 32 * (sr >> 2) + 16 * (sr & 1) + 4 * ((sr >> 1) & 1);
                  *(u32x2*)kp = (u32x2){pkc(o[0][e] * kd[0], o[1][e] * kd[1]), pkc(o[2][e] * kd[2], o[3][e] * kd[3])}; *(u32x2*)(kp + 8) = (u32x2){pkc(o[4][e] * kd[4], o[5][e] * kd[5]), pkc(o[6][e] * kd[6], o[7][e] * kd[7])}; } } }
        __syncthreads();
        { const int which = w >> 2, it = w & 3, i = 16 * it + ii; LAS bf16_t* SX = which ? QN : KN;
          bf16x8 sf[4];
#pragma unroll
          for (int ks = 0; ks < 4; ++ks) sf[ks] = *(const LAS bf16x8*)(SX + i * SPK + 32 * ks + 8 * g);
          const float gi = gcs[i], bi = bts[i];
#pragma unroll
          for (int jt = 0; jt < 4; ++jt) { f32x4 d = (f32x4){0.f, 0.f, 0.f, 0.f};
              if (jt <= it) {
#pragma unroll
                  for (int ks = 0; ks < 4; ++ks) d = MFMA16(*(const LAS bf16x8*)(KN + (16 * jt + ii) * SPK + 32 * ks + 8 * g), sf[ks], d); }
              const f32x4 gj = *(const LAS f32x4*)(gcs + 16 * jt + 4 * g); float v[4];
#pragma unroll
              for (int e = 0; e < 4; ++e) { const int j = 16 * jt + 4 * g + e; const float dec = __expf(fminf(gi - gj[e], 0.f));
                  v[e] = which ? ((j <= i) ? d[e] * dec : 0.f) : ((j < i) ? d[e] * bi * dec : 0.f); }
              if (which) *(u32x2*)(GATT + (size_t)item * 4096 + i * 64 + 32 * (jt >> 1) + 8 * g + 4 * (jt & 1)) = (u32x2){pkc(v[0], v[1]), pkc(v[2], v[3])};
              else *(LAS f32x4*)(LM + i * LMP + 16 * jt + 4 * g) = (f32x4){v[0], v[1], v[2], v[3]}; } }
        __syncthreads();
        { const int c16 = lane & 15, kg = lane >> 4;
          if (w < 4) { const int b0 = 16 * w; float Xd[16];
#pragma unroll
              for (int r = 0; r < 16; ++r) { float a0 = (r == 0 ? 0.f : 0.f); a0 = fmaxf(1.0f - fabsf((float)c16 - (float)r), 0.f); float a1 = 0.f;
#pragma unroll
                  for (int m = 0; m < r; ++m) { const float lv = LM[(b0 + r) * LMP + b0 + m]; if (m & 1) a1 -= lv * Xd[m]; else a0 -= lv * Xd[m]; }
                  Xd[r] = a0 + a1; }
#pragma unroll
              for (int r = 0; r < 16; ++r) if (kg == 0) XI[(b0 + r) * LMP + b0 + c16] = Xd[r]; }
          __syncthreads();
#pragma unroll
          for (int d = 1; d <= 3; ++d) {
              if (w + d <= 3) { const int bi = w + d, bj = w; f32x4 M = (f32x4){0.f, 0.f, 0.f, 0.f};
#pragma unroll
                  for (int mm = 0; mm < d; ++mm) { const int bm = bj + mm;
#pragma unroll
                      for (int st = 0; st < 4; ++st) M = __builtin_amdgcn_mfma_f32_16x16x4f32(LM[(16 * bi + c16) * LMP + 16 * bm + 4 * st + kg], XI[(16 * bm + 4 * st + kg) * LMP + 16 * bj + c16], M, 0, 0, 0); }
                  f32x4 R = (f32x4){0.f, 0.f, 0.f, 0.f};
#pragma unroll
                  for (int e = 0; e < 4; ++e) R = __builtin_amdgcn_mfma_f32_16x16x4f32(XI[(16 * bi + c16) * LMP + 16 * bi + 4 * kg + e], M[e], R, 0, 0, 0);
#pragma unroll
                  for (int e = 0; e < 4; ++e) XI[(16 * bi + 4 * kg + e) * LMP + 16 * bj + c16] = -R[e]; }
              __syncthreads(); }
          { const int tid2 = w * 64 + lane, i = tid2 >> 3, c0 = (tid2 & 7) * 8; float xv[8];
#pragma unroll
            for (int e = 0; e < 8; ++e) xv[e] = ((c0 >> 4) <= (i >> 4)) ? XI[i * LMP + c0 + e] : 0.f;
            *(LAS u32x4*)(TI + i * SPT + c0) = (u32x4){pkc(xv[0], xv[1]), pkc(xv[2], xv[3]), pkc(xv[4], xv[5]), pkc(xv[6], xv[7])}; } }
        __syncthreads();
        { const int it = w & 3, hf = w >> 2, q = (lane & 15) >> 2, p = lane & 3;
          bf16x8 tf[2];
#pragma unroll
          for (int ks = 0; ks < 2; ++ks) tf[ks] = *(const LAS bf16x8*)(TI + (16 * it + ii) * SPT + 32 * ks + 8 * g);
#pragma unroll
          for (int d8 = 0; d8 < 8; ++d8) { const int dt = 8 * hf + d8; f32x4 acc = (f32x4){0.f, 0.f, 0.f, 0.f};
#pragma unroll
              for (int ks = 0; ks < 2; ++ks) {
                  const s16x4 ta = __builtin_amdgcn_ds_read_tr16_b64_v4i16((LAS s16x4*)(VB + (32 * ks + 8 * g + q) * SPV + 16 * dt + 4 * p));
                  const s16x4 tb = __builtin_amdgcn_ds_read_tr16_b64_v4i16((LAS s16x4*)(VB + (32 * ks + 8 * g + 4 + q) * SPV + 16 * dt + 4 * p));
                  acc = MFMA16(tf[ks], ((bf16x8){ta[0], ta[1], ta[2], ta[3], tb[0], tb[1], tb[2], tb[3]}), acc); }
              const int dv = 16 * dt + ii;
              *(u32x2*)(QKV + (size_t)(t0 + (dv >> 2)) * 8192 + 4096 + h * 256 + (dv & 3) * 64 + 16 * it + 4 * g) = (u32x2){pkc(acc[0], acc[1]), pkc(acc[2], acc[3])}; }
#pragma unroll
          for (int k4 = 0; k4 < 4; ++k4) { const int kt = 4 * hf + k4; f32x4 acc = (f32x4){0.f, 0.f, 0.f, 0.f};
#pragma unroll
              for (int ks = 0; ks < 2; ++ks) {
                  const s16x4 ta = __builtin_amdgcn_ds_read_tr16_b64_v4i16((LAS s16x4*)(KB + (32 * ks + 8 * g + q) * SPK + 16 * kt + 4 * p));
                  const s16x4 tb = __builtin_amdgcn_ds_read_tr16_b64_v4i16((LAS s16x4*)(KB + (32 * ks + 8 * g + 4 + q) * SPK + 16 * kt + 4 * p));
                  acc = MFMA16(((bf16x8){ta[0], ta[1], ta[2], ta[3], tb[0], tb[1], tb[2], tb[3]}), tf[ks], acc); }
              *(u32x2*)(GW + (size_t)item * 8192 + (16 * it + ii) * 128 + 32 * (kt >> 1) + 8 * g + 4 * (kt & 1)) = (u32x2){pkc(acc[0], acc[1]), pkc(acc[2], acc[3])}; } }
        __syncthreads();
    }
}

#define MFMA32(F, S, A) __builtin_amdgcn_mfma_f32_32x32x16_bf16((F), (S), (A), 0, 0, 0)
typedef float f32x16 __attribute__((ext_vector_type(16)));
constexpr int GS_W = 0, GS_QD = GS_W + 64 * SPK * 2, GS_KT = GS_QD + 64 * SPK * 2, GS_AT = GS_KT + 128 * SPT * 2, GS_BUF = GS_AT + 64 * SPT * 2;
constexpr int GS_OBUF = 64 * SPT * 2;
static_assert(2 * GS_BUF + 2 * GS_OBUF <= LDS_CTL_OFF, "gdn_scan LDS map");
__device__ __forceinline__ bf16x8 pack8(const f32x16& x, int s) {
    const u32x4 v = (u32x4){pkc(x[8 * s], x[8 * s + 1]), pkc(x[8 * s + 2], x[8 * s + 3]), pkc(x[8 * s + 4], x[8 * s + 5]), pkc(x[8 * s + 6], x[8 * s + 7])};
    return __builtin_bit_cast(bf16x8, v); }
__device__ __forceinline__ void gdn_scan(const Ctx& C, int hh, int unit) {
    const int head = unit >> 1, dvh = unit & 1;
    const bf16_t* QKV = (const bf16_t*)(C.ws + WS_QKV); const bf16_t* GW = (const bf16_t*)(C.ws + WS_GW); const bf16_t* GATT = (const bf16_t*)(C.ws + WS_GATT);
    const float* GCD = (const float*)(C.ws + WS_GCD); bf16_t* GO = (bf16_t*)(C.out + (size_t)TH * 2048);
    const int lane = C.lane, w = C.wave;
    constexpr int NC = TH / 64;
    if (w >= 4) {
        const int lt = C.tid - 256; u32x4 pw[4], pq[4], pk[4], pa[2];
#define GS_LOAD(c_) do { const size_t item_ = (size_t)(c_) * 16 + head; const int t0_ = (c_) * 64; \
        _Pragma("unroll") for (int k = 0; k < 4; ++k) { const int q = lt + 256 * k, i = q >> 4, pc = q & 15; \
            pw[k] = *(const u32x4*)(GW + item_ * 8192 + i * 128 + pc * 8); \
            pq[k] = *(const u32x4*)(QKV + (size_t)(t0_ + i) * 8192 + head * 128 + pc * 8); \
            pk[k] = *(const u32x4*)(QKV + (size_t)(t0_ + i) * 8192 + 2048 + head * 128 + pc * 8); } \
        _Pragma("unroll") for (int k = 0; k < 2; ++k) { const int q = lt + 256 * k; pa[k] = *(const u32x4*)(GATT + item_ * 4096 + q * 8); } } while (0)
#define GS_STORE(b_) do { LAS unsigned char* B_ = C.lds + (b_) * GS_BUF; \
        _Pragma("unroll") for (int k = 0; k < 4; ++k) { const int q = lt + 256 * k, i = q >> 4, pc = q & 15; \
            *(LAS u32x4*)((LAS bf16_t*)(B_ + GS_W) + i * SPK + pc * 8) = pw[k]; *(LAS u32x4*)((LAS bf16_t*)(B_ + GS_QD) + i * SPK + pc * 8) = pq[k]; \
            *(LAS u32x4*)((LAS bf16_t*)(B_ + GS_KT) + (2 * i + (pc >> 3)) * SPT + (pc & 7) * 8) = pk[k]; } \
        _Pragma("unroll") for (int k = 0; k < 2; ++k) { const int q = lt + 256 * k; *(LAS u32x4*)((LAS bf16_t*)(B_ + GS_AT) + (q >> 3) * SPT + (q & 7) * 8) = pa[k]; } } while (0)
        GS_LOAD(0); GS_STORE(0); GS_LOAD(1);
        __syncthreads();
        for (int c = 0; c < NC; ++c) {
            if (c + 1 < NC) GS_STORE((c + 1) & 1);
            if (c + 2 < NC) GS_LOAD(c + 2);
            __syncthreads();
        }
#undef GS_LOAD
#undef GS_STORE
    } else {
        const int r = lane & 31, h2 = lane >> 5, dv = dvh * 128 + w * 32 + r;
        float* stp = (float*)(C.ws + WS_ST_GDN) + (size_t)(head * 256 + dv) * 128;
        f32x16 Sacc[4];
#pragma unroll
        for (int td = 0; td < 4; ++td)
#pragma unroll
            for (int q = 0; q < 4; ++q) { const f32x4 v = *(const f32x4*)(stp + 32 * td + 8 * q + 4 * h2);
                Sacc[td][4 * q] = v.x; Sacc[td][4 * q + 1] = v.y; Sacc[td][4 * q + 2] = v.z; Sacc[td][4 * q + 3] = v.w; }
        u32x2 urA[2][4], urB[2][4]; float cdA, cdB;
#define GS_ULOAD(c_, UR, CD) do { const int t0_ = (c_) * 64; \
        _Pragma("unroll") for (int ti = 0; ti < 2; ++ti) _Pragma("unroll") for (int q = 0; q < 4; ++q) \
            UR[ti][q] = *(const u32x2*)(QKV + (size_t)(t0_ + (dv >> 2)) * 8192 + 4096 + head * 256 + (dv & 3) * 64 + 32 * ti + 8 * q + 4 * h2); \
        CD = GCD[(size_t)(c_) * 16 + head]; } while (0)
        GS_ULOAD(0, urA, cdA);
        __syncthreads();
#define GS_FRAG(P_, off_) cat44(*(const LAS u32x2*)((P_) + (off_)), *(const LAS u32x2*)((P_) + (off_) + 8))
#define GS_LW(dst, P_, ti_, tp_) do { _Pragma("unroll") for (int t2 = 0; t2 < 2; ++t2) _Pragma("unroll") for (int s = 0; s < 2; ++s) dst[t2 * 2 + s] = GS_FRAG(P_, (32 * (ti_) + r) * SPK + 32 * (2 * (tp_) + t2) + 16 * s + 4 * h2); __builtin_amdgcn_sched_barrier(0); } while (0)
#define GS_MW(acc_, fr_, tp_) do { _Pragma("unroll") for (int t2 = 0; t2 < 2; ++t2) _Pragma("unroll") for (int s = 0; s < 2; ++s) acc_ = MFMA32(fr_[t2 * 2 + s], SB[2 * (tp_) + t2][s], acc_); } while (0)
#define GS_MWO(acc_, fr_, tp_) do { _Pragma("unroll") for (int t2 = 0; t2 < 2; ++t2) _Pragma("unroll") for (int s = 0; s < 2; ++s) acc_ = MFMA32(SB[2 * (tp_) + t2][s], fr_[t2 * 2 + s], acc_); } while (0)
#define GS_LA(dst, ti_) do { _Pragma("unroll") for (int tj = 0; tj < 2; ++tj) _Pragma("unroll") for (int s = 0; s < 2; ++s) dst[tj * 2 + s] = GS_FRAG(AT, (32 * (ti_) + r) * SPT + 32 * tj + 16 * s + 4 * h2); __builtin_amdgcn_sched_barrier(0); } while (0)
#define GS_LK(dst, td_) do { _Pragma("unroll") for (int ti = 0; ti < 2; ++ti) _Pragma("unroll") for (int s = 0; s < 2; ++s) dst[ti * 2 + s] = GS_FRAG(KT, (32 * (td_) + r) * SPT + 32 * ti + 16 * s + 4 * h2); __builtin_amdgcn_sched_barrier(0); } while (0)
#define GS_MV(acc_, fr_) do { _Pragma("unroll") for (int tj = 0; tj < 2; ++tj) _Pragma("unroll") for (int s = 0; s < 2; ++s) acc_ = MFMA32(fr_[tj * 2 + s], VBf[tj][s], acc_); } while (0)
#define GS_MVO(acc_, fr_) do { _Pragma("unroll") for (int tj = 0; tj < 2; ++tj) _Pragma("unroll") for (int s = 0; s < 2; ++s) acc_ = MFMA32(VBf[tj][s], fr_[tj * 2 + s], acc_); } while (0)
#define GS_BODY(c, UR, CD, URN, CDN) do { \
            const LAS unsigned char* B_ = C.lds + ((c) & 1) * GS_BUF; \
            const LAS bf16_t* Wl = (const LAS bf16_t*)(B_ + GS_W); const LAS bf16_t* QD = (const LAS bf16_t*)(B_ + GS_QD); \
            const LAS bf16_t* KT = (const LAS bf16_t*)(B_ + GS_KT); const LAS bf16_t* AT = (const LAS bf16_t*)(B_ + GS_AT); \
            const int t0 = (c) * 64; \
            bf16x8 SB[4][2]; \
            _Pragma("unroll") for (int td = 0; td < 4; ++td) { SB[td][0] = pack8(Sacc[td], 0); SB[td][1] = pack8(Sacc[td], 1); } \
            f32x16 T1[2], oacc[2]; bf16x8 f0[4], f1[4]; \
            _Pragma("unroll") for (int ti = 0; ti < 2; ++ti) _Pragma("unroll") for (int e = 0; e < 16; ++e) T1[ti][e] = 0.f; \
            GS_LW(f0, Wl, 0, 0); GS_LW(f1, Wl, 0, 1); \
            GS_MW(T1[0], f0, 0); GS_LW(f0, Wl, 1, 0); \
            GS_MW(T1[0], f1, 1); GS_LW(f1, Wl, 1, 1); \
            GS_MW(T1[1], f0, 0); GS_LW(f0, QD, 0, 0); \
            GS_MW(T1[1], f1, 1); GS_LW(f1, QD, 0, 1); \
            _Pragma("unroll") for (int ti = 0; ti < 2; ++ti) _Pragma("unroll") for (int e = 0; e < 16; ++e) oacc[ti][e] = 0.f; \
            GS_MWO(oacc[0], f0, 0); GS_LW(f0, QD, 1, 0); \
            bf16x8 VBf[2][2]; \
            _Pragma("unroll") for (int ti = 0; ti < 2; ++ti) { \
                _Pragma("unroll") for (int q = 0; q < 4; ++q) { T1[ti][4 * q] = bflo(UR[ti][q].x) - T1[ti][4 * q]; T1[ti][4 * q + 1] = bfhi(UR[ti][q].x) - T1[ti][4 * q + 1]; \
                    T1[ti][4 * q + 2] = bflo(UR[ti][q].y) - T1[ti][4 * q + 2]; T1[ti][4 * q + 3] = bfhi(UR[ti][q].y) - T1[ti][4 * q + 3]; } \
                VBf[ti][0] = pack8(T1[ti], 0); VBf[ti][1] = pack8(T1[ti], 1); } \
            const float cd = CD; \
            if ((c) + 1 < NC) GS_ULOAD((c) + 1, URN, CDN); \
            GS_MWO(oacc[0], f1, 1); GS_LW(f1, QD, 1, 1); \
            GS_MWO(oacc[1], f0, 0); GS_LA(f0, 0); \
            GS_MWO(oacc[1], f1, 1); GS_LA(f1, 1); \
            GS_MVO(oacc[0], f0); GS_LK(f0, 0); \
            GS_MVO(oacc[1], f1); GS_LK(f1, 1); \
            _Pragma("unroll") for (int td = 0; td < 4; ++td) Sacc[td] = Sacc[td] * cd; \
            GS_MV(Sacc[0], f0); GS_LK(f0, 2); \
            GS_MV(Sacc[1], f1); GS_LK(f1, 3); \
            GS_MV(Sacc[2], f0); GS_MV(Sacc[3], f1); \
            _Pragma("unroll") for (int ti = 0; ti < 2; ++ti) _Pragma("unroll") for (int q = 0; q < 4; ++q) \
                    *(u32x2*)(GO + (size_t)(t0 + 32 * ti + r) * 4096 + head * 256 + dvh * 128 + w * 32 + 8 * q + 4 * h2) = (u32x2){pkc(oacc[ti][4 * q], oacc[ti][4 * q + 1]), pkc(oacc[ti][4 * q + 2], oacc[ti][4 * q + 3])}; \
            __syncthreads(); \
        } while (0)
        for (int c2 = 0; c2 < NC; c2 += 2) { GS_BODY(c2, urA, cdA, urB, cdB); GS_BODY(c2 + 1, urB, cdB, urA, cdA); }
#undef GS_BODY
#undef GS_FRAG
#undef GS_LW
#undef GS_MW
#undef GS_LA
#undef GS_LK
#undef GS_MV
#undef GS_ULOAD
        { int l2 = lane; asm volatile("" : "+v"(l2)); const int dv2 = dvh * 128 + w * 32 + (l2 & 31), hh2 = l2 >> 5;
          float* sp2 = (float*)(C.ws + WS_ST_GDN) + (size_t)(head * 256 + dv2) * 128 + 4 * hh2;
#pragma unroll
          for (int td = 0; td < 4; ++td)
#pragma unroll
            for (int q = 0; q < 4; ++q) *(f32x4*)(sp2 + 32 * td + 8 * q) = (f32x4){Sacc[td][4 * q], Sacc[td][4 * q + 1], Sacc[td][4 * q + 2], Sacc[td][4 * q + 3]}; }
    }
}


__device__ __forceinline__ bf16x8 pack44(const f32x4& a, const f32x4& b) { const u32x4 v = (u32x4){pkc(a[0], a[1]), pkc(a[2], a[3]), pkc(b[0], b[1]), pkc(b[2], b[3])}; return __builtin_bit_cast(bf16x8, v); }
__device__ __forceinline__ void gdn_scan16(const Ctx& C, int hh, int unit) {
    const int head = unit >> 2, dvq = unit & 3;
    const bf16_t* QKV = (const bf16_t*)(C.ws + WS_QKV); const bf16_t* GW = (const bf16_t*)(C.ws + WS_GW); const bf16_t* GATT = (const bf16_t*)(C.ws + WS_GATT);
    const float* GCD = (const float*)(C.ws + WS_GCD); bf16_t* GO = (bf16_t*)(C.out + (size_t)TH * 2048);
    const int lane = C.lane, w = C.wave;
    constexpr int NC = TH / 64;
    if (w >= 4) {
        const int lt = C.tid - 256; u32x4 pwA[4], pqA[4], pkA[4], paA[2], pwB[4], pqB[4], pkB[4], paB[2];
#define GS_LOAD(c_, pw, pq, pk, pa) do { const size_t item_ = (size_t)(c_) * 16 + head; const int t0_ = (c_) * 64; \
        _Pragma("unroll") for (int k = 0; k < 4; ++k) { const int q = lt + 256 * k, i = q >> 4, pc = q & 15; \
            pw[k] = *(const u32x4*)(GW + item_ * 8192 + i * 128 + pc * 8); \
            pq[k] = *(const u32x4*)(QKV + (size_t)(t0_ + i) * 8192 + head * 128 + pc * 8); \
            pk[k] = *(const u32x4*)(QKV + (size_t)(t0_ + i) * 8192 + 2048 + head * 128 + pc * 8); } \
        _Pragma("unroll") for (int k = 0; k < 2; ++k) { const int q = lt + 256 * k; pa[k] = *(const u32x4*)(GATT + item_ * 4096 + q * 8); } } while (0)
#define GS_STORE(b_, pw, pq, pk, pa) do { LAS unsigned char* B_ = C.lds + (b_) * GS_BUF; \
        _Pragma("unroll") for (int k = 0; k < 4; ++k) { const int q = lt + 256 * k, i = q >> 4, pc = q & 15; \
            *(LAS u32x4*)((LAS bf16_t*)(B_ + GS_W) + i * SPK + pc * 8) = pw[k]; *(LAS u32x4*)((LAS bf16_t*)(B_ + GS_QD) + i * SPK + pc * 8) = pq[k]; \
            *(LAS u32x4*)((LAS bf16_t*)(B_ + GS_KT) + (2 * i + (pc >> 3)) * SPT + (pc & 7) * 8) = pk[k]; } \
        _Pragma("unroll") for (int k = 0; k < 2; ++k) { const int q = lt + 256 * k; *(LAS u32x4*)((LAS bf16_t*)(B_ + GS_AT) + (q >> 3) * SPT + (q & 7) * 8) = pa[k]; } } while (0)
#define GS_OCOPY(c_) do { const LAS bf16_t* OS_ = (const LAS bf16_t*)(C.lds + 2 * GS_BUF + ((c_) & 1) * GS_OBUF); \
        _Pragma("unroll") for (int k = 0; k < 2; ++k) { const int q = lt + 256 * k, row = q >> 3, pc = q & 7; \
            *(u32x4*)(GO + (size_t)((c_) * 64 + row) * 4096 + head * 256 + dvq * 64 + pc * 8) = *(const LAS u32x4*)(OS_ + row * SPT + pc * 8); } } while (0)
        GS_LOAD(0, pwA, pqA, pkA, paA); GS_STORE(0, pwA, pqA, pkA, paA); GS_LOAD(1, pwB, pqB, pkB, paB); GS_LOAD(2, pwA, pqA, pkA, paA);
        __syncthreads();
        for (int c = 0; c < NC; c += 2) {
            if (c + 1 < NC) GS_STORE(1, pwB, pqB, pkB, paB);
            if (c + 3 < NC) GS_LOAD(c + 3, pwB, pqB, pkB, paB);
            if (c > 0) GS_OCOPY(c - 1);
            __syncthreads();
            if (c + 2 < NC) GS_STORE(0, pwA, pqA, pkA, paA);
            if (c + 4 < NC) GS_LOAD(c + 4, pwA, pqA, pkA, paA);
            GS_OCOPY(c);
            __syncthreads();
        }
        GS_OCOPY(NC - 1);
#undef GS_LOAD
#undef GS_STORE
#undef GS_OCOPY
    } else {
        const int i16 = lane & 15, g = lane >> 4, dv = dvq * 64 + w * 16 + i16;
        float* stp = (float*)(C.ws + WS_ST_GDN) + (size_t)(head * 256 + dv) * 128 + 4 * g;
        f32x4 Sacc[8];
#pragma unroll
        for (int td = 0; td < 8; ++td) Sacc[td] = *(const f32x4*)(stp + 16 * td);
        u32x2 urA[4], urB[4]; float cdA, cdB;
#define G16_ULOAD(c_, UR, CD) do { const int t0_ = (c_) * 64; \
        _Pragma("unroll") for (int ti = 0; ti < 4; ++ti) UR[ti] = *(const u32x2*)(QKV + (size_t)(t0_ + (dv >> 2)) * 8192 + 4096 + head * 256 + (dv & 3) * 64 + 16 * ti + 4 * g); \
        CD = GCD[(size_t)(c_) * 16 + head]; } while (0)
        G16_ULOAD(0, urA, cdA); G16_ULOAD(1, urB, cdB);
        __syncthreads();
#define G16_FR(P_, row_, pitch_, j_) (*(const LAS bf16x8*)((P_) + (row_) * (pitch_) + 32 * (j_) + 8 * g))
#define G16_BODY(c, UR, CD) do { \
            const LAS unsigned char* B_ = C.lds + ((c) & 1) * GS_BUF; \
            const LAS bf16_t* Wl = (const LAS bf16_t*)(B_ + GS_W); const LAS bf16_t* QD = (const LAS bf16_t*)(B_ + GS_QD); \
            const LAS bf16_t* KT = (const LAS bf16_t*)(B_ + GS_KT); const LAS bf16_t* AT = (const LAS bf16_t*)(B_ + GS_AT); \
            const int t0 = (c) * 64; \
            bf16x8 SB[4]; \
            _Pragma("unroll") for (int j = 0; j < 4; ++j) SB[j] = pack44(Sacc[2 * j], Sacc[2 * j + 1]); \
            const float cd = CD; \
            _Pragma("unroll") for (int td = 0; td < 8; ++td) Sacc[td] = Sacc[td] * cd;     \
            f32x4 T1[4], oacc[4]; bf16x8 fw[16], fq[16]; \
            _Pragma("unroll") for (int ti = 0; ti < 4; ++ti) { T1[ti] = (f32x4){0.f, 0.f, 0.f, 0.f}; oacc[ti] = (f32x4){0.f, 0.f, 0.f, 0.f}; } \
            _Pragma("unroll") for (int ti = 0; ti < 4; ++ti) _Pragma("unroll") for (int j = 0; j < 4; ++j) fw[ti * 4 + j] = G16_FR(Wl, 16 * ti + i16, SPK, j); \
            __builtin_amdgcn_sched_barrier(0); \
            _Pragma("unroll") for (int ti = 0; ti < 4; ++ti) _Pragma("unroll") for (int j = 0; j < 4; ++j) fq[ti * 4 + j] = G16_FR(QD, 16 * ti + i16, SPK, j); \
            _Pragma("unroll") for (int ti = 0; ti < 4; ++ti) _Pragma("unroll") for (int j = 0; j < 4; ++j) T1[ti] = MFMA16(fw[ti * 4 + j], SB[j], T1[ti]); \
            __builtin_amdgcn_sched_barrier(0); \
            _Pragma("unroll") for (int ti = 0; ti < 4; ++ti) _Pragma("unroll") for (int jj = 0; jj < 2; ++jj) fw[ti * 2 + jj] = G16_FR(AT, 16 * ti + i16, SPT, jj); \
            _Pragma("unroll") for (int ti = 0; ti < 4; ++ti) _Pragma("unroll") for (int j = 0; j < 4; ++j) oacc[ti] = MFMA16(SB[j], fq[ti * 4 + j], oacc[ti]); \
            __builtin_amdgcn_sched_barrier(0); \
            f32x4 vn[4]; \
            _Pragma("unroll") for (int ti = 0; ti < 4; ++ti) { vn[ti][0] = bflo(UR[ti].x) - T1[ti][0]; vn[ti][1] = bfhi(UR[ti].x) - T1[ti][1]; vn[ti][2] = bflo(UR[ti].y) - T1[ti][2]; vn[ti][3] = bfhi(UR[ti].y) - T1[ti][3]; } \
            const bf16x8 VB0 = pack44(vn[0], vn[1]), VB1 = pack44(vn[2], vn[3]); \
            if ((c) + 2 < NC) G16_ULOAD((c) + 2, UR, CD); \
            _Pragma("unroll") for (int td = 0; td < 8; ++td) { fq[td * 2] = G16_FR(KT, 16 * td + i16, SPT, 0); fq[td * 2 + 1] = G16_FR(KT, 16 * td + i16, SPT, 1); } \
            _Pragma("unroll") for (int ti = 0; ti < 4; ++ti) { oacc[ti] = MFMA16(VB0, fw[ti * 2], oacc[ti]); oacc[ti] = MFMA16(VB1, fw[ti * 2 + 1], oacc[ti]); } \
            __builtin_amdgcn_sched_barrier(0); \
            _Pragma("unroll") for (int td = 0; td < 8; ++td) { Sacc[td] = MFMA16(fq[td * 2], VB0, Sacc[td]); Sacc[td] = MFMA16(fq[td * 2 + 1], VB1, Sacc[td]); } \
            { LAS bf16_t* OS_ = (LAS bf16_t*)(C.lds + 2 * GS_BUF + ((c) & 1) * GS_OBUF); \
              _Pragma("unroll") for (int ti = 0; ti < 4; ++ti) *(LAS u32x2*)(OS_ + (16 * ti + i16) * SPT + w * 16 + 4 * g) = (u32x2){pkc(oacc[ti][0], oacc[ti][1]), pkc(oacc[ti][2], oacc[ti][3])}; } \
            __syncthreads(); \
        } while (0)
        for (int c2 = 0; c2 < NC; c2 += 2) { G16_BODY(c2, urA, cdA); G16_BODY(c2 + 1, urB, cdB); }
#undef G16_BODY
#undef G16_FR
#undef G16_ULOAD
        { int l2 = lane; asm volatile("" : "+v"(l2)); const int dv2 = dvq * 64 + w * 16 + (l2 & 15);
          float* sp2 = (float*)(C.ws + WS_ST_GDN) + (size_t)(head * 256 + dv2) * 128 + 4 * (l2 >> 4);
#pragma unroll
          for (int td = 0; td < 8; ++td) *(f32x4*)(sp2 + 16 * td) = Sacc[td]; }
    }
}

__device__ __forceinline__ void p4_post(const Ctx& C) {
    const int lane = C.lane, w = C.wave;
    const bf16_t* XBC = (const bf16_t*)(C.ws + WS_XBC); bf16_t* ZS = (bf16_t*)(C.ws + WS_ZSSM);
    const bf16_t* GOB = (const bf16_t*)(C.out + (size_t)TH * 2048); bf16_t* ZG = (bf16_t*)(C.ws + WS_ZGDN);
    const int cs = w * 512 + lane * 8, cgd = w * 512 + lane * 8, cw = (lane & 31) * 8;
    const f32x4 sw0 = *(const f32x4*)(C.in(I_SNW) + cs), sw1 = *(const f32x4*)(C.in(I_SNW) + cs + 4);
    const f32x4 gw0 = *(const f32x4*)(C.in(I_GNW) + cw), gw1 = *(const f32x4*)(C.in(I_GNW) + cw + 4);
    for (int tb = C.bid * 4; tb < TH; tb += C.G * 4) {
        u32x4 yv[4], zv[4], ov[4], gv[4];
#pragma unroll
        for (int b = 0; b < 4; ++b) { const size_t t = tb + b;
            yv[b] = *(const u32x4*)(XBC + t * 6144 + cs); zv[b] = *(const u32x4*)(ZS + t * 4096 + cs);
            ov[b] = *(const u32x4*)(GOB + t * 4096 + cgd); gv[b] = *(const u32x4*)(ZG + t * 4096 + cgd); }
#pragma unroll
        for (int b = 0; b < 4; ++b) { const size_t t = tb + b;
            { float y[8]; unpack8(yv[b], y); float z[8]; unpack8(zv[b], z); float ss = 0.f;
#pragma unroll
              for (int e = 0; e < 8; ++e) { y[e] *= siluf_(z[e]); ss += y[e] * y[e]; }
              const float sc = rsqrtf(wave_sum(ss) * (1.0f / 512.0f) + EPS);
              u32x4 o; o.x = pk2(y[0] * sc * sw0.x, y[1] * sc * sw0.y); o.y = pk2(y[2] * sc * sw0.z, y[3] * sc * sw0.w); o.z = pk2(y[4] * sc * sw1.x, y[5] * sc * sw1.y); o.w = pk2(y[6] * sc * sw1.z, y[7] * sc * sw1.w);
              *(u32x4*)(ZS + t * 4096 + cs) = o; }
            { float o[8]; unpack8(ov[b], o); float z[8]; unpack8(gv[b], z); float ss = 0.f;
#pragma unroll
              for (int e = 0; e < 8; ++e) ss += o[e] * o[e];
#pragma unroll
              for (int m = 1; m < 32; m <<= 1) ss += __shfl_xor(ss, m);
              const float sc = rsqrtf(ss * (1.0f / 256.0f) + EPS);
              u32x4 r; r.x = pk2(o[0] * sc * gw0.x * siluf_(z[0]), o[1] * sc * gw0.y * siluf_(z[1])); r.y = pk2(o[2] * sc * gw0.z * siluf_(z[2]), o[3] * sc * gw0.w * siluf_(z[3]));
              r.z = pk2(o[4] * sc * gw1.x * siluf_(z[4]), o[5] * sc * gw1.y * siluf_(z[5])); r.w = pk2(o[6] * sc * gw1.z * siluf_(z[6]), o[7] * sc * gw1.w * siluf_(z[7]));
              *(u32x4*)(ZG + t * 4096 + cgd) = r; } }
    }
}

template <int N> __device__ __forceinline__ void bitonic_sort_desc(unsigned (&a)[N]) {
#pragma unroll
    for (int k = 2; k <= N; k <<= 1)
#pragma unroll
        for (int j = k >> 1; j > 0; j >>= 1)
#pragma unroll
            for (int i = 0; i < N; ++i) { const int l = i ^ j; if (l > i) { const bool desc = ((i & k) == 0);
                const unsigned hi = a[i] > a[l] ? a[i] : a[l], lo = a[i] > a[l] ? a[l] : a[i]; a[i] = desc ? hi : lo; a[l] = desc ? lo : hi; } }
}
template <int N> __device__ __forceinline__ void bitonic_merge_desc(unsigned (&a)[N]) {
#pragma unroll
    for (int j = N >> 1; j > 0; j >>= 1)
#pragma unroll
        for (int i = 0; i < N; ++i) { const int l = i ^ j; if (l > i) { const unsigned hi = a[i] > a[l] ? a[i] : a[l], lo = a[i] > a[l] ? a[l] : a[i]; a[i] = hi; a[l] = lo; } }
}
template <int M> __device__ __forceinline__ void merge_lanes16(unsigned (&a)[16]) {
    unsigned o[16];
#pragma unroll
    for (int i = 0; i < 16; ++i) o[i] = (unsigned)__shfl_xor((int)a[i], M);
#pragma unroll
    for (int i = 0; i < 16; ++i) a[i] = a[i] > o[15 - i] ? a[i] : o[15 - i];
    bitonic_merge_desc<16>(a);
}
__device__ __forceinline__ unsigned f2key(float f) { const unsigned u = __float_as_uint(f); return u ^ ((unsigned)((int)u >> 31) | 0x80000000u); }
__device__ __forceinline__ float key2f(unsigned k) { return __uint_as_float((k & 0x80000000u) ? (k & 0x7fffffffu) : ~k); }
__device__ __forceinline__ void p9_scores(const Ctx& C) {
    const bf16_t* Q = (const bf16_t*)(C.ws + WS_Q); const bf16_t* SKB = (const bf16_t*)(C.ws + WS_SKB);
    int* PIDX = (int*)(C.ws + WS_PIDX); float* PGATE = (float*)(C.ws + WS_PGATE);
    const int lane = C.lane, h = C.wave, fr = lane & 15, fq = lane >> 4;
    LAS int* tab = (LAS int*)C.lds + h * 512;
    const float* SSQ = (const float*)(C.ws + WS_SSQ); float* RSTD = (float*)(C.ws + WS_RSTD);
    for (int tile = C.bid; tile < T / 16; tile += C.G) {
        const int tok0 = tile * 16;
        float rstd;
        { const f32x4 s0 = *(const f32x4*)(SSQ + (size_t)(tok0 + fr) * 32 + fq * 8), s1 = *(const f32x4*)(SSQ + (size_t)(tok0 + fr) * 32 + fq * 8 + 4);
          float ss = ((s0.x + s0.y) + (s0.z + s0.w)) + ((s1.x + s1.y) + (s1.z + s1.w)); ss += __shfl_xor(ss, 16); ss += __shfl_xor(ss, 32);
          rstd = rsqrtf(ss * (1.0f / 2048.0f) + EPS); if (h == 0 && fq == 0) RSTD[tok0 + fr] = rstd; }
        unsigned K[2][16];
#pragma unroll
        for (int p = 0; p < 2; ++p) {
            bf16x8 a[4];
#pragma unroll
            for (int ks = 0; ks < 4; ++ks) a[ks] = *(const bf16x8*)(Q + (size_t)(tok0 + fr) * 2048 + h * 256 + p * 128 + ks * 32 + fq * 8);
            unsigned ka[16], kb[16];
#pragma unroll
            for (int n4 = 0; n4 < 2; ++n4) { bf16x8 b[16];
#pragma unroll
                for (int q = 0; q < 16; ++q) b[q] = *(const bf16x8*)(SKB + (size_t)((h * 2 + p) * 128 + (n4 * 4 + (q >> 2)) * 16 + fr) * 128 + (q & 3) * 32 + fq * 8);
                __builtin_amdgcn_sched_barrier(0);
#pragma unroll
                for (int n2 = 0; n2 < 4; ++n2) { const int nt = n4 * 4 + n2; f32x4 acc = (f32x4){0.f, 0.f, 0.f, 0.f};
#pragma unroll
                    for (int ks = 0; ks < 4; ++ks) acc = __builtin_amdgcn_mfma_f32_16x16x32_bf16(b[n2 * 4 + ks], a[ks], acc, 0, 0, 0);
#pragma unroll
                    for (int i = 0; i < 4; ++i) { const unsigned key = (f2key(acc[i]) & ~127u) | (unsigned)(127 - (nt * 16 + 4 * fq + i));
                        if (n4 == 0) ka[n2 * 4 + i] = key; else kb[n2 * 4 + i] = key; } } }
            bitonic_sort_desc<16>(ka); bitonic_sort_desc<16>(kb);
#pragma unroll
            for (int i = 0; i < 16; ++i) ka[i] = ka[i] > kb[15 - i] ? ka[i] : kb[15 - i];
            bitonic_merge_desc<16>(ka);
            merge_lanes16<16>(ka); merge_lanes16<32>(ka);
#pragma unroll
            for (int i = 0; i < 16; ++i) K[p][i] = ka[i];
        }
        if (fq == 0) {
#pragma unroll
            for (int i = 0; i < 16; ++i) { tab[fr * 32 + i] = 127 - (int)(K[0][i] & 127u); tab[fr * 32 + 16 + i] = 127 - (int)(K[1][i] & 127u); } }
        unsigned cd[16];
        { unsigned ck[52]; int nc = 0;
#pragma unroll
          for (int i = 0; i < 16; ++i)
#pragma unroll
              for (int j = 0; j < 16; ++j) if ((i + 1) * (j + 1) <= 16) { ck[nc] = (f2key(key2f(K[0][i] & ~127u) + key2f(K[1][j] & ~127u)) & ~255u) | (unsigned)(255 - (i * 16 + j)); ++nc; }
          ck[50] = 0u; ck[51] = 0u;
#pragma unroll
          for (int m = 0; m < 13; ++m) cd[m] = fq == 0 ? ck[4 * m] : (fq == 1 ? ck[4 * m + 1] : (fq == 2 ? ck[4 * m + 2] : ck[4 * m + 3]));
          cd[13] = 0u; cd[14] = 0u; cd[15] = 0u; }
        bitonic_sort_desc<16>(cd);
        merge_lanes16<16>(cd); merge_lanes16<32>(cd);
        LDS_WAIT(); asm volatile("" ::: "memory");
        float ex[16]; int id[16]; float sum = 0.f; const float mx = key2f(cd[0] & ~255u);
#pragma unroll
        for (int it = 0; it < 16; ++it) { ex[it] = __expf((key2f(cd[it] & ~255u) - mx) * rstd);     sum += ex[it]; const int flat = 255 - (int)(cd[it] & 255u);
            id[it] = tab[fr * 32 + (flat >> 4)] * 128 + tab[fr * 32 + 16 + (flat & 15)]; }
        const float inv = 1.0f / sum;
        int4 oi; f32x4 og;
        oi.x = fq == 0 ? id[0] : (fq == 1 ? id[4] : (fq == 2 ? id[8] : id[12])); oi.y = fq == 0 ? id[1] : (fq == 1 ? id[5] : (fq == 2 ? id[9] : id[13]));
        oi.z = fq == 0 ? id[2] : (fq == 1 ? id[6] : (fq == 2 ? id[10] : id[14])); oi.w = fq == 0 ? id[3] : (fq == 1 ? id[7] : (fq == 2 ? id[11] : id[15]));
        og.x = (fq == 0 ? ex[0] : (fq == 1 ? ex[4] : (fq == 2 ? ex[8] : ex[12]))) * inv; og.y = (fq == 0 ? ex[1] : (fq == 1 ? ex[5] : (fq == 2 ? ex[9] : ex[13]))) * inv;
        og.z = (fq == 0 ? ex[2] : (fq == 1 ? ex[6] : (fq == 2 ? ex[10] : ex[14]))) * inv; og.w = (fq == 0 ? ex[3] : (fq == 1 ? ex[7] : (fq == 2 ? ex[11] : ex[15]))) * inv;
        *(int4*)(PIDX + (size_t)(tok0 + fr) * 128 + h * 16 + 4 * fq) = oi;
        *(f32x4*)(PGATE + (size_t)(tok0 + fr) * 128 + h * 16 + 4 * fq) = og;
        LDS_WAIT(); asm volatile("" ::: "memory");
    }
}

__device__ __forceinline__ void p10_peer_naive(const Ctx& C) {
    const int gw = C.bid * NWAVES + C.wave, NGW = C.G * NWAVES, lane = C.lane;
    const bf16_t* HN = (const bf16_t*)(C.ws + WS_XN); const int* PIDX = (const int*)(C.ws + WS_PIDX); const float* PGATE = (const float*)(C.ws + WS_PGATE);
    const float* U = C.in(I_PU); const float* V = C.in(I_PV);
    for (int t = gw; t < T; t += NGW) {
        f32x4 hv[8], acc[8];
#pragma unroll
        for (int j = 0; j < 8; ++j) { const u32x2 w = *((const u32x2*)(HN + (size_t)t * 2048) + lane + 64 * j); hv[j] = (f32x4){bflo(w.x), bfhi(w.x), bflo(w.y), bfhi(w.y)}; acc[j] = (f32x4){0.f, 0.f, 0.f, 0.f}; }
        const int ia = PIDX[(size_t)t * 128 + lane], ib = PIDX[(size_t)t * 128 + 64 + lane];
        const float ga = PGATE[(size_t)t * 128 + lane], gb = PGATE[(size_t)t * 128 + 64 + lane];
#pragma unroll 2
        for (int e = 0; e < 128; ++e) {
            const int id = __shfl(e < 64 ? ia : ib, e & 63); const float gt = __shfl(e < 64 ? ga : gb, e & 63);
            const f32x4* ur = (const f32x4*)(U + (size_t)id * 2048) + lane; float d = 0.f;
#pragma unroll
            for (int j = 0; j < 8; ++j) { const f32x4 uu = ur[64 * j]; d += (uu.x * hv[j].x + uu.y * hv[j].y) + (uu.z * hv[j].z + uu.w * hv[j].w); }
            d = wave_sum(d);
            const float cf = gt * 0.5f * d * (1.0f + erff(d * 0.70710678118f));
            const f32x4* vr = (const f32x4*)(V + (size_t)id * 2048) + lane;
#pragma unroll
            for (int j = 0; j < 8; ++j) acc[j] += vr[64 * j] * cf;
        }
        f32x4* hr = (f32x4*)(C.out + (size_t)t * 2048) + lane; float ss = 0.f;
#pragma unroll
        for (int j = 0; j < 8; ++j) { acc[j] += hr[64 * j]; ss += (acc[j].x * acc[j].x + acc[j].y * acc[j].y) + (acc[j].z * acc[j].z + acc[j].w * acc[j].w); }
        const float r = rsqrtf(wave_sum(ss) * (1.0f / 2048.0f) + EPS);
        const f32x4* fw = (const f32x4*)C.in(I_FINW) + lane;
#pragma unroll
        for (int j = 0; j < 8; ++j) hr[64 * j] = acc[j] * r * fw[64 * j];
    }
}


constexpr float U8_SCALE = 64.0f;
constexpr float U4_SCALE = 128.0f, V8_SCALE = 8.0f;
constexpr float V4_SCALE = 8.0f;
__device__ __forceinline__ unsigned q4(float x) { return (unsigned)(int)fminf(fmaxf(rintf(x), -8.0f), 7.0f) & 15u; }
__device__ __forceinline__ void tables_to_fp8(const Ctx& C, int first_wg) {
    const int gt = (C.bid - first_wg) * NTHREADS + C.tid, NGT = (C.G - first_wg) * NTHREADS;
    const f32x4* U = (const f32x4*)C.in(I_PU); const f32x4* V = (const f32x4*)C.in(I_PV); u32x4* U8 = (u32x4*)(C.ws + WS_U8); u32x4* V8 = (u32x4*)(C.ws + WS_V8);
    constexpr int NPU = 16384 * 2048 / 32;
    for (int it = gt; it < 2 * NPU; it += NGT) { const int which = it >= NPU, i = which ? it - NPU : it;
        const int pc = i & 7, ps = (i >> 3) & 7;
        const f32x4* src = (which ? V : U) + (size_t)(i >> 6) * 512 + ps * 64 + pc; const f32x4* fw = (const f32x4*)C.in(I_FNW) + ps * 64 + pc; u32x4 o; const float sc = which ? V4_SCALE : U4_SCALE; const unsigned lx = which ? 8u : 0u;
#pragma unroll
        for (int d = 0; d < 4; ++d) { f32x4 a = src[16 * d] * sc, b = src[16 * d + 8] * sc; if (!which) { a = a * fw[16 * d]; b = b * fw[16 * d + 8]; }
            o[d] = ((q4(a.x) << 4) | (q4(b.x) ^ lx)) | (((q4(a.y) << 4) | (q4(b.y) ^ lx)) << 8) | (((q4(a.z) << 4) | (q4(b.z) ^ lx)) << 16) | (((q4(a.w) << 4) | (q4(b.w) ^ lx)) << 24); }
        (which ? V8 : U8)[i] = o; }
}
__device__ __forceinline__ void peer_load4(const unsigned char* T8, int i0, int i1, int i2, int i3, int lane, u32x4 (&r)[4][2]) {
    const unsigned char* b0 = T8 + (size_t)i0 * 2048 + lane * 16; const unsigned char* b1 = T8 + (size_t)i1 * 2048 + lane * 16;
    const unsigned char* b2 = T8 + (size_t)i2 * 2048 + lane * 16; const unsigned char* b3 = T8 + (size_t)i3 * 2048 + lane * 16;
    r[0][0] = *(const u32x4*)b0; r[0][1] = *(const u32x4*)(b0 + 1024); r[1][0] = *(const u32x4*)b1; r[1][1] = *(const u32x4*)(b1 + 1024);
    r[2][0] = *(const u32x4*)b2; r[2][1] = *(const u32x4*)(b2 + 1024); r[3][0] = *(const u32x4*)b3; r[3][1] = *(const u32x4*)(b3 + 1024);
}
__device__ __forceinline__ void p10_peer(const Ctx& C) {
    const int gw = C.bid * NWAVES + C.wave, NGW = C.G * NWAVES, lane = C.lane;
    const bf16_t* HN = (const bf16_t*)(C.ws + WS_XN); const int* PIDX = (const int*)(C.ws + WS_PIDX); const float* PGATE = (const float*)(C.ws + WS_PGATE);
    const unsigned char* U8 = C.ws + WS_U8; const unsigned char* V8 = C.ws + WS_V8;
    for (int t = gw; t < T; t += NGW) {
        float hv[2][16], acc[2][16];
#pragma unroll
        for (int j = 0; j < 2; ++j) { const u32x4 a = *(const u32x4*)(HN + (size_t)t * 2048 + j * 1024 + lane * 16), b = *(const u32x4*)(HN + (size_t)t * 2048 + j * 1024 + lane * 16 + 8);
            float f[8]; unpack8(a, f);
#pragma unroll
            for (int e = 0; e < 8; ++e) hv[j][e] = f[e];
            unpack8(b, f);
#pragma unroll
            for (int e = 0; e < 8; ++e) { hv[j][8 + e] = f[e]; }
#pragma unroll
            for (int e = 0; e < 16; ++e) acc[j][e] = 0.f; }
        const int ia = PIDX[(size_t)t * 128 + lane], ib = PIDX[(size_t)t * 128 + 64 + lane];
        const float ga = PGATE[(size_t)t * 128 + lane], gb = PGATE[(size_t)t * 128 + 64 + lane];
        u32x4 uA[4][2], vv[4][2];
#define PEER_IDS(g_) const int sl_ = ((g_) * 4) & 63; const int src_ = (g_) < 16 ? ia : ib; \
        const int i0 = __builtin_amdgcn_readlane(src_, sl_), i1 = __builtin_amdgcn_readlane(src_, sl_ + 1), i2 = __builtin_amdgcn_readlane(src_, sl_ + 2), i3 = __builtin_amdgcn_readlane(src_, sl_ + 3)
#define PEER_COMPUTE(g_, UU) do { \
        { PEER_IDS(g_); peer_load4(V8, i0, i1, i2, i3, lane, vv); } \
        float p[4]; \
        _Pragma("unroll") for (int e = 0; e < 4; ++e) { float s0 = 0.f, s1 = 0.f; \
            _Pragma("unroll") for (int j = 0; j < 2; ++j) _Pragma("unroll") for (int d = 0; d < 4; ++d) { const unsigned wv = UU[e][j][d]; \
                const f32x2 lo = __builtin_amdgcn_cvt_pk_f32_fp8(wv, false), hi = __builtin_amdgcn_cvt_pk_f32_fp8(wv, true); \
                s0 += lo.x * hv[j][4 * d] + hi.x * hv[j][4 * d + 2]; s1 += lo.y * hv[j][4 * d + 1] + hi.y * hv[j][4 * d + 3]; } \
            p[e] = s0 + s1; } \
        if ((g_) + 1 < 32) { PEER_IDS((g_) + 1); peer_load4(U8, i0, i1, i2, i3, lane, UU); }     \
        const bool b0 = lane & 1, b1 = lane & 2; \
        float kA = b0 ? p[2] : p[0], kB = b0 ? p[3] : p[1]; const float sA = b0 ? p[0] : p[2], sB = b0 ? p[1] : p[3]; \
        kA += __shfl_xor(sA, 1); kB += __shfl_xor(sB, 1); \
        float kk = b1 ? kB : kA; const float ss = b1 ? kA : kB; kk += __shfl_xor(ss, 2); \
        kk += __shfl_xor(kk, 4); kk += __shfl_xor(kk, 8); kk += __shfl_xor(kk, 16); kk += __shfl_xor(kk, 32); \
        const int el = 2 * (lane & 1) + ((lane >> 1) & 1);                        \
        const float gt = __shfl((g_) < 16 ? ga : gb, (((g_) * 4) & 63) + el); \
        const float dd = kk * (1.0f / U8_SCALE); const float cfl = gt * 0.5f * dd * (1.0f + erff(dd * 0.70710678118f)) * (1.0f / V8_SCALE); \
        const int cfi = __float_as_int(cfl); float cf[4]; cf[0] = __int_as_float(__builtin_amdgcn_readlane(cfi, 0)); cf[1] = __int_as_float(__builtin_amdgcn_readlane(cfi, 2)); cf[2] = __int_as_float(__builtin_amdgcn_readlane(cfi, 1)); cf[3] = __int_as_float(__builtin_amdgcn_readlane(cfi, 3)); \
        _Pragma("unroll") for (int e = 0; e < 4; ++e) _Pragma("unroll") for (int j = 0; j < 2; ++j) _Pragma("unroll") for (int d = 0; d < 4; ++d) { const unsigned wv = vv[e][j][d]; \
            const f32x2 lo = __builtin_amdgcn_cvt_pk_f32_fp8(wv, false), hi = __builtin_amdgcn_cvt_pk_f32_fp8(wv, true); \
            acc[j][4 * d] += cf[e] * lo.x; acc[j][4 * d + 1] += cf[e] * lo.y; acc[j][4 * d + 2] += cf[e] * hi.x; acc[j][4 * d + 3] += cf[e] * hi.y; } } while (0)
        { PEER_IDS(0); peer_load4(U8, i0, i1, i2, i3, lane, uA); }
#pragma unroll 1
        for (int g = 0; g < 32; ++g) { PEER_COMPUTE(g, uA); }
#undef PEER_IDS
#undef PEER_COMPUTE
        float* hr = C.out + (size_t)t * 2048; float ss2 = 0.f;
#pragma unroll
        for (int j = 0; j < 2; ++j)
#pragma unroll
            for (int d = 0; d < 4; ++d) { const f32x4 hq = *(const f32x4*)(hr + j * 1024 + lane * 16 + 4 * d);
                acc[j][4 * d] += hq.x; acc[j][4 * d + 1] += hq.y; acc[j][4 * d + 2] += hq.z; acc[j][4 * d + 3] += hq.w;
                ss2 += (acc[j][4 * d] * acc[j][4 * d] + acc[j][4 * d + 1] * acc[j][4 * d + 1]) + (acc[j][4 * d + 2] * acc[j][4 * d + 2] + acc[j][4 * d + 3] * acc[j][4 * d + 3]); }
        const float rr = rsqrtf(wave_sum(ss2) * (1.0f / 2048.0f) + EPS);
        const float* fw = C.in(I_FINW);
#pragma unroll
        for (int j = 0; j < 2; ++j)
#pragma unroll
            for (int d = 0; d < 4; ++d) { const f32x4 wq = *(const f32x4*)(fw + j * 1024 + lane * 16 + 4 * d);
                *(f32x4*)(hr + j * 1024 + lane * 16 + 4 * d) = (f32x4){acc[j][4 * d] * rr * wq.x, acc[j][4 * d + 1] * rr * wq.y, acc[j][4 * d + 2] * rr * wq.z, acc[j][4 * d + 3] * rr * wq.w}; }
    }
}


template <int M0> __device__ __forceinline__ void reduce16to2(const float (&v)[16], int lane, float& o0, float& o1) {
    float w8[8], w4[4];
    { const bool b = lane & M0;
#pragma unroll
      for (int i = 0; i < 8; ++i) { const float keep = b ? v[8 + i] : v[i], send = b ? v[i] : v[8 + i]; w8[i] = keep + __shfl_xor(send, M0); } }
    { const bool b = lane & (2 * M0);
#pragma unroll
      for (int i = 0; i < 4; ++i) { const float keep = b ? w8[4 + i] : w8[i], send = b ? w8[i] : w8[4 + i]; w4[i] = keep + __shfl_xor(send, 2 * M0); } }
    { const bool b = lane & (4 * M0);
      const float k0 = b ? w4[2] : w4[0], s0 = b ? w4[0] : w4[2], k1 = b ? w4[3] : w4[1], s1 = b ? w4[1] : w4[3];
      o0 = k0 + __shfl_xor(s0, 4 * M0); o1 = k1 + __shfl_xor(s1, 4 * M0); }
}
__device__ __forceinline__ void p10_peer_sliced(const Ctx& C) {
    const int gw = C.bid * NWAVES + C.wave, NGW = C.G * NWAVES, lane = C.lane, eg = lane >> 3, c = lane & 7, tk = lane >> 3;
    const bf16_t* HN = (const bf16_t*)(C.ws + WS_XN); const int* PIDX = (const int*)(C.ws + WS_PIDX); const float* PGATE = (const float*)(C.ws + WS_PGATE);
    const unsigned char* U8 = C.ws + WS_U8; const unsigned char* V8 = C.ws + WS_V8; const float* RSTD = (const float*)(C.ws + WS_RSTD);
    unsigned char* H8 = C.ws + WS_Q;
    LAS unsigned* offs = (LAS unsigned*)(C.lds + C.wave * 8192);
    LAS float* coefl = (LAS float*)(C.lds + C.wave * 8192 + 4096);
    LAS float* hsc = (LAS float*)(C.lds + 65536 + C.wave * 64);
    LAS unsigned char* cqb = (LAS unsigned char*)(C.lds + 65536 + 512 + C.wave * 1024);
    const int jc = 8 * (c & 1) + 4 * ((c >> 1) & 1) + 2 * ((c >> 2) & 1);
    const int je = 8 * (eg & 1) + 4 * ((eg >> 1) & 1) + 2 * ((eg >> 2) & 1);
    const int e0 = 8 * jc + eg, e1 = 8 * (jc + 1) + eg;
    for (int tb = gw * 8; tb < T; tb += NGW * 8) {
#pragma unroll
        for (int k = 0; k < 8; ++k) { offs[k * 128 + lane] = (unsigned)PIDX[(size_t)(tb + k) * 128 + lane] << 10; offs[k * 128 + 64 + lane] = (unsigned)PIDX[(size_t)(tb + k) * 128 + 64 + lane] << 10;
            coefl[k * 128 + lane] = 0.f; coefl[k * 128 + 64 + lane] = 0.f; }
#pragma unroll 1
        for (int k = 0; k < 8; ++k) { const bf16_t* hp = HN + (size_t)(tb + k) * 2048 + lane * 32; float x[32]; float am = 0.f;
#pragma unroll
            for (int q = 0; q < 4; ++q) { const u32x4 hv = *(const u32x4*)(hp + 8 * q);
                x[8 * q] = bflo(hv.x); x[8 * q + 1] = bfhi(hv.x); x[8 * q + 2] = bflo(hv.y); x[8 * q + 3] = bfhi(hv.y); x[8 * q + 4] = bflo(hv.z); x[8 * q + 5] = bfhi(hv.z); x[8 * q + 6] = bflo(hv.w); x[8 * q + 7] = bfhi(hv.w); }
#pragma unroll
            for (int j = 0; j < 32; ++j) am = fmaxf(am, fabsf(x[j]));
#pragma unroll
            for (int o = 32; o; o >>= 1) am = fmaxf(am, __shfl_xor(am, o));
            const float inv = am > 0.f ? 127.0f / am : 0.f;
            if (lane == 0) hsc[k] = am * (1.0f / 127.0f);
            unsigned w[8];
#pragma unroll
            for (int j = 0; j < 8; ++j) { const int q0 = (int)rintf(x[4 * j] * inv), q1 = (int)rintf(x[4 * j + 1] * inv), q2 = (int)rintf(x[4 * j + 2] * inv), q3 = (int)rintf(x[4 * j + 3] * inv);
                w[j] = ((unsigned)q0 & 255u) | (((unsigned)q1 & 255u) << 8) | (((unsigned)q2 & 255u) << 16) | ((unsigned)q3 << 24); }
            *(u32x4*)(H8 + (size_t)(tb + k) * 2048 + lane * 32) = (u32x4){w[0], w[1], w[2], w[3]}; *(u32x4*)(H8 + (size_t)(tb + k) * 2048 + lane * 32 + 16) = (u32x4){w[4], w[5], w[6], w[7]}; }
        asm volatile("s_waitcnt vmcnt(0)" ::: "memory");
        LDS_WAIT(); asm volatile("" ::: "memory");
#pragma unroll 1
        for (int s = 0; s < 8; ++s) {
            const unsigned char* ub = U8 + s * 128 + c * 16;
            int hq[8];
#pragma unroll
            for (int q = 0; q < 8; ++q) hq[q] = *(const int*)(H8 + (size_t)(tb + tk) * 2048 + s * 256 + 32 * q + 4 * c);
#pragma unroll 1
            for (int j = 0; j < 8; j += 2) {
                const LAS u32x4* o4 = (const LAS u32x4*)(offs + tk * 128 + 16 * j);
                u32x4 of[8];
#pragma unroll
                for (int q = 0; q < 8; ++q) of[q] = o4[q];
                u32x4 r[32];
#pragma unroll
                for (int i = 0; i < 32; ++i) r[i] = *(const u32x4*)(ub + of[i >> 2][i & 3]);
#pragma unroll
                for (int jj = 0; jj < 2; ++jj) {
                    float v[16];
#pragma unroll
                    for (int i = 0; i < 16; ++i) { int a = 0;
#pragma unroll
                        for (int d = 0; d < 4; ++d) { const int wv = (int)r[16 * jj + i][d];
                            a = __builtin_amdgcn_sdot4(wv & (int)0xF0F0F0F0, hq[2 * d], a, false); a = __builtin_amdgcn_sdot4((wv << 4) & (int)0xF0F0F0F0, hq[2 * d + 1], a, false); }
                        v[i] = (float)a; }
                    float o0, o1; reduce16to2<1>(v, lane, o0, o1);
                    LAS float* cp = coefl + tk * 128 + 16 * (j + jj) + jc; cp[0] += o0; cp[1] += o1; }
            }
        }
        LDS_WAIT(); asm volatile("" ::: "memory");
#pragma unroll 1
        for (int k = 0; k < 8; ++k) { float cv[2];
#pragma unroll
            for (int r2 = 0; r2 < 2; ++r2) { const int e = r2 ? e1 : e0; const float dd = coefl[k * 128 + e] * (1.0f / (16.0f * U4_SCALE)) * hsc[k] * RSTD[tb + k];
                cv[r2] = PGATE[(size_t)(tb + k) * 128 + e] * 0.5f * dd * (1.0f + erff(dd * 0.70710678118f)); }
            float am = fmaxf(fabsf(cv[0]), fabsf(cv[1]));
#pragma unroll
            for (int o = 32; o; o >>= 1) am = fmaxf(am, __shfl_xor(am, o));
            const float inv = am > 0.f ? 127.0f / am : 0.f;
            if (lane == 0) hsc[8 + k] = am * (1.0f / (127.0f * V4_SCALE));
#pragma unroll
            for (int r2 = 0; r2 < 2; ++r2) { const int e = r2 ? e1 : e0; cqb[k * 128 + e] = (unsigned char)((int)rintf(cv[r2] * inv) & 255); } }
        LDS_WAIT(); asm volatile("" ::: "memory");
        int al0 = 0;
#pragma unroll
        for (int q = 0; q < 8; ++q) { const u32x4 cq4 = *(const LAS u32x4*)(cqb + tk * 128 + 16 * q);
            al0 = __builtin_amdgcn_sdot4((int)0xF8F8F8F8, (int)cq4.x, al0, false); al0 = __builtin_amdgcn_sdot4((int)0xF8F8F8F8, (int)cq4.y, al0, false);
            al0 = __builtin_amdgcn_sdot4((int)0xF8F8F8F8, (int)cq4.z, al0, false); al0 = __builtin_amdgcn_sdot4((int)0xF8F8F8F8, (int)cq4.w, al0, false); }
        const float fsc = hsc[8 + tk];
        float ssq = 0.f;
#pragma unroll 1
        for (int s = 0; s < 8; ++s) {
            const unsigned char* vb = V8 + s * 128 + c * 16;
            int acc[32];
#pragma unroll
            for (int q = 0; q < 32; ++q) acc[q] = al0;
#pragma unroll 1
            for (int j = 0; j < 8; j += 2) {
                const LAS u32x4* o4 = (const LAS u32x4*)(offs + tk * 128 + 16 * j);
                u32x4 of[8];
#pragma unroll
                for (int q = 0; q < 8; ++q) of[q] = o4[q];
                u32x4 r[32];
#pragma unroll
                for (int i = 0; i < 32; ++i) r[i] = *(const u32x4*)(vb + of[i >> 2][i & 3]);
                const u32x4 cq4 = *(const LAS u32x4*)(cqb + tk * 128 + 16 * j), cq5 = *(const LAS u32x4*)(cqb + tk * 128 + 16 * j + 16);
                const int cqv[8] = {(int)cq4.x, (int)cq4.y, (int)cq4.z, (int)cq4.w, (int)cq5.x, (int)cq5.y, (int)cq5.z, (int)cq5.w};
#pragma unroll
                for (int g = 0; g < 8; ++g)
#pragma unroll
                    for (int d = 0; d < 4; ++d) { const unsigned A0 = r[4 * g][d], A1 = r[4 * g + 1][d], A2 = r[4 * g + 2][d], A3 = r[4 * g + 3][d];
                        const unsigned p01l = __builtin_amdgcn_perm(A1, A0, 0x05010400u), p01h = __builtin_amdgcn_perm(A1, A0, 0x07030602u), p23l = __builtin_amdgcn_perm(A3, A2, 0x05010400u), p23h = __builtin_amdgcn_perm(A3, A2, 0x07030602u);
                        const unsigned t0 = __builtin_amdgcn_perm(p23l, p01l, 0x05040100u), t1 = __builtin_amdgcn_perm(p23l, p01l, 0x07060302u), t2 = __builtin_amdgcn_perm(p23h, p01h, 0x05040100u), t3 = __builtin_amdgcn_perm(p23h, p01h, 0x07060302u);
                        acc[8 * d + 0] = __builtin_amdgcn_sdot4((int)t0, cqv[g], acc[8 * d + 0], false); acc[8 * d + 4] = __builtin_amdgcn_sdot4((int)(t0 & 0x0F0F0F0Fu), cqv[g], acc[8 * d + 4], false);
                        acc[8 * d + 1] = __builtin_amdgcn_sdot4((int)t1, cqv[g], acc[8 * d + 1], false); acc[8 * d + 5] = __builtin_amdgcn_sdot4((int)(t1 & 0x0F0F0F0Fu), cqv[g], acc[8 * d + 5], false);
                        acc[8 * d + 2] = __builtin_amdgcn_sdot4((int)t2, cqv[g], acc[8 * d + 2], false); acc[8 * d + 6] = __builtin_amdgcn_sdot4((int)(t2 & 0x0F0F0F0Fu), cqv[g], acc[8 * d + 6], false);
                        acc[8 * d + 3] = __builtin_amdgcn_sdot4((int)t3, cqv[g], acc[8 * d + 3], false); acc[8 * d + 7] = __builtin_amdgcn_sdot4((int)(t3 & 0x0F0F0F0Fu), cqv[g], acc[8 * d + 7], false); }
            }
            bf16_t* hp = (bf16_t*)(C.ws + WS_XN) + (size_t)(tb + tk) * 2048 + s * 256 + 4 * c;
#pragma unroll
            for (int d = 0; d < 4; ++d) { const u32x2 ha = *(const u32x2*)(hp + 64 * d), hb = *(const u32x2*)(hp + 64 * d + 32);
                const float x0 = bflo(ha.x) + (float)(acc[8 * d] - acc[8 * d + 4]) * (0.0625f * fsc), x1 = bfhi(ha.x) + (float)(acc[8 * d + 1] - acc[8 * d + 5]) * (0.0625f * fsc),
                            x2 = bflo(ha.y) + (float)(acc[8 * d + 2] - acc[8 * d + 6]) * (0.0625f * fsc), x3 = bfhi(ha.y) + (float)(acc[8 * d + 3] - acc[8 * d + 7]) * (0.0625f * fsc);
                const float y0 = bflo(hb.x) + (float)acc[8 * d + 4] * fsc, y1 = bfhi(hb.x) + (float)acc[8 * d + 5] * fsc, y2 = bflo(hb.y) + (float)acc[8 * d + 6] * fsc, y3 = bfhi(hb.y) + (float)acc[8 * d + 7] * fsc;
                ssq += ((x0 * x0 + x1 * x1) + (x2 * x2 + x3 * x3)) + ((y0 * y0 + y1 * y1) + (y2 * y2 + y3 * y3));
                *(u32x2*)(hp + 64 * d) = (u32x2){pkc(x0, x1), pkc(x2, x3)}; *(u32x2*)(hp + 64 * d + 32) = (u32x2){pkc(y0, y1), pkc(y2, y3)}; }
        }
        ssq += __shfl_xor(ssq, 1); ssq += __shfl_xor(ssq, 2); ssq += __shfl_xor(ssq, 4);
        const float rr = rsqrtf(ssq * (1.0f / 2048.0f) + EPS);
        asm volatile("s_waitcnt vmcnt(0)" ::: "memory");
#pragma unroll 1
        for (int k = 0; k < 8; ++k) { const float rk = __shfl(rr, 8 * k);
            const u32x2* hr = (const u32x2*)((const bf16_t*)(C.ws + WS_XN) + (size_t)(tb + k) * 2048) + lane; f32x4* orow = (f32x4*)(C.out + (size_t)(tb + k) * 2048) + lane; const f32x4* fw = (const f32x4*)C.in(I_FINW) + lane;
#pragma unroll
            for (int j = 0; j < 8; ++j) { const u32x2 hv = hr[64 * j]; orow[64 * j] = (f32x4){bflo(hv.x), bfhi(hv.x), bflo(hv.y), bfhi(hv.y)} * rk * fw[64 * j]; } }
    }
}

__device__ __forceinline__ Ctx phase_ctx(const Ctx& C0) {
    Ctx C = C0; C.ws = launder_s(C0.ws); C.out = launder_s(C0.out);
    unsigned m_ = ~0u; asm volatile("" : "+s"(m_));
    const int l_ = (int)__builtin_amdgcn_mbcnt_hi(m_, __builtin_amdgcn_mbcnt_lo(m_, 0u));
    C.lane = l_; C.tid = C0.wave * 64 + l_; C.wave = C0.wave;
    return C;
}
constexpr int NPH = 16;
__global__ void __launch_bounds__(NTHREADS, 2) mk_fwd(Args args) {
    extern __shared__ __attribute__((aligned(16))) unsigned char lds_raw[];
    Ctx C0; C0.a = &args;
    C0.out = args.out; C0.ws = args.ws; C0.lds = (LAS unsigned char*)lds_raw;
    C0.tid = 0; C0.lane = 0; C0.wave = __builtin_amdgcn_readfirstlane((int)threadIdx.x >> 6); C0.G = gridDim.x; C0.bid = blockIdx.x;
    const int lo = args.ph_lo, hi = args.ph_hi;
    volatile LAS unsigned* xbw = (volatile LAS unsigned*)(C0.lds + LDS_CTL_OFF);
    if (threadIdx.x < 4) xbw[threadIdx.x] = 0u;
    __syncthreads();
    XcdBarrier bar; bar.bar = (unsigned*)(C0.ws + WS_CTL) + CW_BAR; bar.x = 0; bar.st = xbw;
    if (hi - lo > 1) bar = xcd_barrier_post((unsigned*)(C0.ws + WS_CTL) + CW_BAR, xbw);
#define IN(k) (lo <= (k) && (k) < hi)
#define SEAM(k) do { if (IN(k) && IN((k) + 1)) { XcdBarrier b_ = bar; b_.bar = launder_s(bar.bar); xcd_barrier(b_); } } while (0)

    if (IN(0)) { const Ctx C = phase_ctx(C0); p0_prologue(C); __syncthreads(); SEAM(0); }

    for (int hh = 0; hh < NHALVES; ++hh) {
        const int pb = 1 + 6 * hh;
        if (IN(pb + 0)) { const Ctx C = phase_ctx(C0);
            { pg8::Gemm g{launder_s((const bf16_t*)(C.ws + WS_XN) + (size_t)hh * TH * 2048), launder_s((const bf16_t*)(C.ws + WS_WIN_T)), TH, NP1 - 256, 2048};
              pg8::StaticOrder S; S.init(TH, NP1 - 256, C.G, C.bid);
              EpiProj E{C.ws, C.in(I_GATEB), hh};
              pg8::gemm_phase<EpiProj, pg8::StaticOrder, true, true>(C.lds, g, S, E, C.tid); }
            if (hh == 0) {
                asm volatile("s_waitcnt vmcnt(0)" ::: "memory"); __syncthreads();
                pg8::Gemm g{launder_s((const bf16_t*)(C.ws + WS_XN)), launder_s((const bf16_t*)(C.ws + WS_WIN_T) + (size_t)(NP1 - 256) * 2048), T, 256, 2048};
                pg8::StaticOrder S; S.init(T, 256, C.G, C.bid);
                EpiSmall E{(float*)(C.ws + WS_SMALLF)};
                pg8::gemm_phase<EpiSmall, pg8::StaticOrder, true, true>(C.lds, g, S, E, C.tid); }
            SEAM(pb + 0);
        }
        if (IN(pb + 1)) { const Ctx C = phase_ctx(C0); p2_bc_conv(C, hh); gdn_pre(C, hh); SEAM(pb + 1); }
        if (IN(pb + 2)) { const Ctx C = phase_ctx(C0);
            if (C.bid < 64) gdn_scan16(C, hh, 4 * (2 * (C.bid & 7) + (C.bid >> 5)) + ((C.bid >> 3) & 3));
            else if (C.bid < 192) ssd_chunked(C, hh, 16 * (C.bid & 7) + ((C.bid - 64) >> 3));
            else if (hh == 0) late_weights(C, 192);
            else tables_to_fp8(C, 192);
            SEAM(pb + 2);
        }
        if (IN(pb + 3)) { const Ctx C = phase_ctx(C0); p4_post(C); SEAM(pb + 3); }
        if (IN(pb + 4)) { const Ctx C = phase_ctx(C0);
            pg8::TwoPassOrder S; S.init(TH, 2048, C.G, C.bid);
            pg8::Gemm g{launder_s((const bf16_t*)(C.ws + WS_ZSSM)), launder_s((const bf16_t*)(C.ws + WS_WBS_T)), TH, 2048, 4096, launder_s((const bf16_t*)(C.ws + WS_ZGDN)), launder_s((const bf16_t*)(C.ws + WS_WBG_T))};
            EpiMixF E{C.ws};
            pg8::gemm_phase<EpiMixF, pg8::TwoPassOrder, true, true>(C.lds, g, S, E, C.tid);
            SEAM(pb + 4);
        }
        if (IN(pb + 5)) { const Ctx C = phase_ctx(C0);
            pg8::Gemm g{launder_s((const bf16_t*)(C.ws + WS_MIXED)), launder_s((const bf16_t*)(C.ws + WS_WOUT_T)), TH, 2048, 2048};
            pg8::StaticOrder S; S.init(TH, 2048, C.G, C.bid);
            EpiOut E{C.in(I_X) + (size_t)hh * TH * 2048, (bf16_t*)(C.ws + WS_XN) + (size_t)hh * TH * 2048, (float*)(C.ws + WS_SSQ) + (size_t)hh * TH * 32};
            pg8::gemm_phase<EpiOut, pg8::StaticOrder, true, true>(C.lds, g, S, E, C.tid);
            SEAM(pb + 5);
        }
    }
    if (IN(13)) { const Ctx C = phase_ctx(C0);
        pg8::Gemm g{launder_s((const bf16_t*)(C.ws + WS_XN)), launder_s((const bf16_t*)(C.ws + WS_WQ_T)), T, 2048, 2048};
        pg8::StaticOrder S; S.init(T, 2048, C.G, C.bid);
        EpiQ E{(bf16_t*)(C.ws + WS_Q)};
        pg8::gemm_phase<EpiQ, pg8::StaticOrder, true, true>(C.lds, g, S, E, C.tid);
        SEAM(13);
    }
    if (IN(14)) { const Ctx C = phase_ctx(C0); p9_scores(C); SEAM(14); }
    if (IN(15)) { const Ctx C = phase_ctx(C0); p10_peer_sliced(C); }
#undef IN
#undef SEAM
}
}

extern "C" void kernel_launch(void* const* d_in, const int* in_sizes, int n_in, void* d_out, int out_size, void* d_ws, size_t ws_size, hipStream_t stream) {
    using namespace mk;
    static int grid = 0;
    if (grid == 0) {
        if (n_in != N_IN || out_size != T * D || ws_size < WS_NEED) { fprintf(stderr, "kernel_launch: unexpected problem (n_in %d out %d ws %zu)\n", n_in, out_size, ws_size); grid = -1; return; }
        int dev = 0, cus = 0, per_cu = 0;
        if (hipGetDevice(&dev) != hipSuccess || hipDeviceGetAttribute(&cus, hipDeviceAttributeMultiprocessorCount, dev) != hipSuccess) { grid = -1; return; }
        if (hipFuncSetAttribute((const void*)mk_fwd, hipFuncAttributeMaxDynamicSharedMemorySize, LDS_BYTES) != hipSuccess) { fprintf(stderr, "kernel_launch: hipFuncSetAttribute failed\n"); grid = -1; return; }
        if (hipOccupancyMaxActiveBlocksPerMultiprocessor(&per_cu, (const void*)mk_fwd, NTHREADS, LDS_BYTES) != hipSuccess || per_cu < 1) fprintf(stderr, "kernel_launch: occupancy query says %d\n", per_cu);
        (void)hipGetLastError();
        grid = cus;
        if (grid < 192) { fprintf(stderr, "kernel_launch: %d CUs; the scan phase needs 192 resident workgroups\n", grid); grid = -1; return; }
    }
    if (grid < 0) return;
    (void)hipMemsetAsync((char*)d_ws + WS_CTL, 0, CTL_ZERO_BYTES, stream);
    Args a{};
    for (int i = 0; i < N_IN; ++i) a.in[i] = (const float*)d_in[i];
    a.out = (float*)d_out; a.ws = (unsigned char*)d_ws;
#if MK_ONE_LAUNCH
    a.ph_lo = 0; a.ph_hi = NPH;
    hipLaunchKernelGGL(mk_fwd, dim3(grid), dim3(NTHREADS), LDS_BYTES, stream, a);
#else
    for (int ph = 0; ph < NPH; ++ph) { a.ph_lo = ph; a.ph_hi = ph + 1; hipLaunchKernelGGL(mk_fwd, dim3(grid), dim3(NTHREADS), LDS_BYTES, stream, a); }
#endif
}
```
